# Optimizing an MI355X kernel written in HIP

```python
import jax, jax.numpy as jnp
from jax import lax
import numpy as np

D_MODEL = 1024
BATCH = 8
SEQ = 2048
DEPTH = 1

D_MIX = D_MODEL
D_ATT = D_MIX // 2
D_CONV = D_MIX - D_ATT
HEAD_DIM = 64
N_HEADS = D_ATT // HEAD_DIM
N_IDX_HEADS = 4
IDX_DIM = 64
TOPK_MAX = 256
CONV_WIDTH = 31
Q_BLOCK = 128
EPS = 1e-6
NEG = -1e30

IN_WIDTHS = (D_ATT, HEAD_DIM, HEAD_DIM, D_ATT, N_IDX_HEADS * IDX_DIM, IDX_DIM, N_IDX_HEADS, 2 * D_CONV, D_CONV)
D_IN = sum(IN_WIDTHS)
SPLIT_POINTS = tuple(int(p) for p in np.cumsum(IN_WIDTHS)[:-1])

kernel_name = "hybrid_dsa_conformer_conv_block"


def rmsnorm(x, g):
    xf = x.astype(jnp.float32)
    y = xf * lax.rsqrt(jnp.mean(xf * xf, axis=-1, keepdims=True) + EPS)
    return (y * g.astype(jnp.float32)).astype(x.dtype)


def layernorm(x, g, b):
    xf = x.astype(jnp.float32)
    mu = jnp.mean(xf, axis=-1, keepdims=True)
    var = jnp.mean(jnp.square(xf - mu), axis=-1, keepdims=True)
    y = (xf - mu) * lax.rsqrt(var + EPS)
    return (y * g.astype(jnp.float32) + b.astype(jnp.float32)).astype(x.dtype)


def alibi_slopes(n_heads):
    h = jnp.arange(1, n_heads + 1, dtype=jnp.float32)
    return jnp.exp2(-8.0 * h / n_heads)


def dsa_sparse_attention(q, k, v, q_idx, k_idx, w_idx):
    B, S = q.shape[0], q.shape[1]
    top_k = min(TOPK_MAX, S // 4)
    n_blocks = S // Q_BLOCK
    slopes = alibi_slopes(N_HEADS)
    key_pos = jnp.arange(S, dtype=jnp.int32)
    k_idx_f = k_idx.astype(jnp.float32)
    gather = jax.vmap(lambda arr, ids: arr[ids])

    def one_block(i):
        t0 = i * Q_BLOCK
        qb = lax.dynamic_slice_in_dim(q, t0, Q_BLOCK, axis=1)
        qib = lax.dynamic_slice_in_dim(q_idx, t0, Q_BLOCK, axis=1)
        wib = lax.dynamic_slice_in_dim(w_idx, t0, Q_BLOCK, axis=1)
        t_pos = t0 + jnp.arange(Q_BLOCK, dtype=jnp.int32)
        causal = key_pos[None, :] <= t_pos[:, None]
        logits = jnp.einsum('bthd,bsd->bths', qib.astype(jnp.float32), k_idx_f)
        iscore = jnp.einsum('bth,bths->bts', wib.astype(jnp.float32), jax.nn.relu(logits))
        iscore = jnp.where(causal[None], iscore, NEG)
        _, sel = lax.top_k(iscore, top_k)
        k_sel = gather(k, sel).astype(jnp.float32)
        v_sel = gather(v, sel).astype(jnp.float32)
        s = jnp.einsum('bthd,btkd->bhtk', qb.astype(jnp.float32), k_sel) * (HEAD_DIM ** -0.5)
        dist = (t_pos[None, :, None] - sel).astype(jnp.float32)
        s = s - slopes[None, :, None, None] * dist[:, None]
        valid = sel <= t_pos[None, :, None]
        s = jnp.where(valid[:, None], s, NEG)
        p = jax.nn.softmax(s, axis=-1)
        o = jnp.einsum('bhtk,btkd->bthd', p, v_sel)
        return o.astype(q.dtype)

    out = lax.map(one_block, jnp.arange(n_blocks))
    return out.transpose(1, 0, 2, 3, 4).reshape(B, S, N_HEADS * HEAD_DIM)


def conformer_conv(u_glu, w_dw, b_dw, g_n, b_n, w_pw2, b_pw2):
    a, g = jnp.split(u_glu, 2, axis=-1)
    u = a * jax.nn.sigmoid(g)
    u_pad = jnp.pad(u, ((0, 0), (CONV_WIDTH - 1, 0), (0, 0)))
    y = lax.conv_general_dilated(
        u_pad, w_dw[:, None, :].astype(u.dtype), window_strides=(1,), padding='VALID',
        dimension_numbers=('NWC', 'WIO', 'NWC'), feature_group_count=D_CONV) + b_dw
    y = jax.nn.silu(layernorm(y, g_n, b_n))
    return y @ w_pw2 + b_pw2


def setup_inputs(seed: int = 0) -> dict:
    key = jax.random.key(seed)
    ks = jax.random.split(key, 16)
    nrm = jax.random.normal
    f32 = jnp.float32
    return {
        "x": nrm(ks[0], (BATCH, SEQ, D_MODEL), f32),
        "c": nrm(ks[1], (BATCH, D_MODEL), f32),
        "w_ada": nrm(ks[2], (DEPTH, D_MODEL, 3 * D_MODEL), f32) * (0.5 * D_MODEL ** -0.5),
        "b_ada": nrm(ks[3], (DEPTH, 3 * D_MODEL), f32) * 0.02,
        "g_pre": 1.0 + 0.1 * nrm(ks[4], (DEPTH, D_MODEL), f32),
        "w_in": nrm(ks[5], (DEPTH, D_MODEL, D_IN), f32) * (D_MODEL ** -0.5),
        "w_dw": nrm(ks[6], (DEPTH, CONV_WIDTH, D_CONV), f32) * (CONV_WIDTH ** -0.5),
        "b_dw": nrm(ks[7], (DEPTH, D_CONV), f32) * 0.02,
        "g_cnorm": 1.0 + 0.1 * nrm(ks[8], (DEPTH, D_CONV), f32),
        "b_cnorm": nrm(ks[9], (DEPTH, D_CONV), f32) * 0.02,
        "w_pw2": nrm(ks[10], (DEPTH, D_CONV, D_CONV), f32) * (D_CONV ** -0.5),
        "b_pw2": nrm(ks[11], (DEPTH, D_CONV), f32) * 0.02,
        "w_out": nrm(ks[12], (DEPTH, D_MIX, D_MODEL), f32) * (D_MIX ** -0.5),
        "g_post": 1.0 + 0.1 * nrm(ks[13], (DEPTH, D_MODEL), f32),
    }


def reference(x, c, w_ada, b_ada, g_pre, w_in, w_dw, b_dw, g_cnorm, b_cnorm, w_pw2, b_pw2, w_out, g_post):
    B, S, _ = x.shape
    c_act = jax.nn.silu(c)
    for l in range(DEPTH):
        mod = c_act @ w_ada[l] + b_ada[l]
        shift, scale, gate = jnp.split(mod, 3, axis=-1)
        h = rmsnorm(x, g_pre[l]) * (1.0 + scale[:, None, :]) + shift[:, None, :]
        proj = h @ w_in[l]
        q, k, v, g_att, q_i, k_i, w_i, u_glu, g_conv = jnp.split(proj, SPLIT_POINTS, axis=-1)
        q = q.reshape(B, S, N_HEADS, HEAD_DIM)
        q_i = q_i.reshape(B, S, N_IDX_HEADS, IDX_DIM)
        y_att = dsa_sparse_attention(q, k, v, q_i, k_i, w_i) * jax.nn.silu(g_att)
        y_conv = conformer_conv(u_glu, w_dw[l], b_dw[l], g_cnorm[l], b_cnorm[l], w_pw2[l], b_pw2[l]) * jax.nn.silu(g_conv)
        y = jnp.concatenate([y_att, y_conv], axis=-1) @ w_out[l]
        x = x + gate[:, None, :] * rmsnorm(y, g_post[l])
    return x
```

```cpp
#include <hip/hip_runtime.h>
#include <cstdio>
#include <cstdint>
namespace pg8 {
#define PG8_LAS __attribute__((address_space(3)))
typedef unsigned short bf16_t;
typedef short bf16x8 __attribute__((ext_vector_type(8)));
typedef float f32x4 __attribute__((ext_vector_type(4)));
typedef unsigned u32x4 __attribute__((ext_vector_type(4)));
constexpr int BM = 256, BK = 64, HALF = 128, HTB = HALF * BK * 2  , STAGE_BYTES = 8 * HTB, NXCD = 8, WGM = 8;

__host__ __device__ __forceinline__ int lds_byte(int r, int c) { const int st = (r >> 4) * 2 + (c >> 5), rr = r & 15, cc = c & 31, ob = rr * 64 + cc * 2; return st * 1024 + (ob ^ (((ob >> 9) & 1) << 5)); }
__host__ __device__ __forceinline__ void stage_rc(int b, int& R, int& C) { const int st = b / 1024, sb = b % 1024, swz = sb ^ (((sb >> 9) & 1) << 5); R = (st >> 1) * 16 + swz / 64; C = (st & 1) * 32 + (swz % 64) / 2; }
__host__ __device__ __forceinline__ int perm32(int rho) { const int n = rho >> 4, i = rho & 15; return 8 * (i >> 2) + 4 * n + (i & 3); }

struct Unit { int pm, pn; };
struct Gemm { const bf16_t* A; const bf16_t* Bt; int M, N, K; };

struct StaticOrder {
    int nM, nN, nwg, G, c;
    __host__ __device__ void init(int M, int N, int G_, int c_) { nM = M / BM; nN = N / BM; nwg = nM * nN; G = G_; c = c_; }
    __host__ __device__ bool next(int i, Unit& u) const {
        const long L = (long)i * G + c; if (L >= nwg) return false;
        int wgid = (int)L; { const int q = nwg / NXCD, r = nwg % NXCD, xcd = wgid % NXCD, off = wgid / NXCD; wgid = (xcd < r ? xcd * (q + 1) : r * (q + 1) + (xcd - r) * q) + off; }
        const int nig = WGM * nN, gid = wgid / nig, fm = gid * WGM, gsz = (nM - fm) < WGM ? (nM - fm) : WGM;
        u.pm = fm + ((wgid % nig) % gsz); u.pn = (wgid % nig) / gsz; return true;
    }
    __device__ __forceinline__ void a_ready(const Unit&) const {}
    __device__ __forceinline__ void done(const Unit&) const {}
};

__device__ __forceinline__ unsigned cvt_pk_bf16(float lo, float hi) { unsigned r; asm volatile("v_cvt_pk_bf16_f32 %0, %1, %2" : "=v"(r) : "v"(lo), "v"(hi)); return r; }
typedef float f32x2 __attribute__((ext_vector_type(2)));

__device__ __forceinline__ float sigm_f(float x) { return __builtin_amdgcn_rcpf(1.0f + __builtin_amdgcn_exp2f(-1.4426950408889634f * x)); }
__device__ __forceinline__ float silu_f(float x) { return x * sigm_f(x); }
__device__ __forceinline__ f32x4 silu4(f32x4 v) { return (f32x4){silu_f(v[0]), silu_f(v[1]), silu_f(v[2]), silu_f(v[3])}; }
__device__ __forceinline__ void store8(bf16_t* p, f32x4 v0, f32x4 v1) { u32x4 w; w.x = cvt_pk_bf16(v0[0], v0[1]); w.y = cvt_pk_bf16(v0[2], v0[3]); w.z = cvt_pk_bf16(v1[0], v1[1]); w.w = cvt_pk_bf16(v1[2], v1[3]); *(u32x4*)p = w; }
__device__ __forceinline__ float bflo(unsigned w) { return __uint_as_float(w << 16); }
__device__ __forceinline__ float bfhi(unsigned w) { return __uint_as_float(w & 0xffff0000u); }

struct EpiF32 {
    static constexpr bool PERM = false, AFTER_DRAIN = false;
    float* C; int ldc;
    __device__ __forceinline__ void operator()(const f32x4 (&acc)[2][2][4][2], const Unit& u, int wr, int wc, int fr, int fq) const {
        const int row0 = u.pm * BM + wr * 64 + fr, col0 = u.pn * BM + wc * 32 + 4 * fq;
#pragma unroll
        for (int ai = 0; ai < 2; ++ai)
#pragma unroll
            for (int m = 0; m < 4; ++m) { float* rowp = C + (size_t)(row0 + ai * HALF + m * 16) * ldc + col0;
#pragma unroll
                for (int bj = 0; bj < 2; ++bj)
#pragma unroll
                    for (int n = 0; n < 2; ++n) *(f32x4*)(rowp + bj * HALF + n * 16) = acc[ai][bj][m][n]; }
    }
};

struct InProjOut { bf16_t *Qb, *Kb, *Vb, *GAb, *QIb, *KIb, *Ub, *GCb; float* WI; };
struct EpiInProj {
    static constexpr bool PERM = true, AFTER_DRAIN = false;
    InProjOut o; float qscale;
    __device__ __forceinline__ void operator()(const f32x4 (&acc)[2][2][4][2], const Unit& u, int wr, int wc, int fr, int fq) const {
        const int row0 = u.pm * BM + wr * 64 + fr, cb = wc * 32 + 8 * fq, pn = u.pn;
#pragma unroll
        for (int ai = 0; ai < 2; ++ai)
#pragma unroll
            for (int m = 0; m < 4; ++m) {
                const size_t row = (size_t)(row0 + ai * HALF + m * 16);
                if (pn < 2) {
#pragma unroll
                    for (int bj = 0; bj < 2; ++bj) store8(o.Qb + row * 512 + pn * 256 + bj * HALF + cb, acc[ai][bj][m][0] * qscale, acc[ai][bj][m][1] * qscale);
                } else if (pn < 4) {
#pragma unroll
                    for (int bj = 0; bj < 2; ++bj) store8(o.GAb + row * 512 + (pn - 2) * 256 + bj * HALF + cb, silu4(acc[ai][bj][m][0]), silu4(acc[ai][bj][m][1]));
                } else if (pn == 4) {
#pragma unroll
                    for (int bj = 0; bj < 2; ++bj) store8(o.QIb + row * 256 + bj * HALF + cb, acc[ai][bj][m][0], acc[ai][bj][m][1]);
                } else if (pn == 5) {
                    if (wc < 2) { store8(o.Kb + row * 64 + cb, acc[ai][0][m][0], acc[ai][0][m][1]); store8(o.KIb + row * 64 + cb, acc[ai][1][m][0], acc[ai][1][m][1]); }
                    else { store8(o.Vb + row * 64 + (cb - 64), acc[ai][0][m][0], acc[ai][0][m][1]); if (wc == 2 && fq == 0) *(f32x4*)(o.WI + row * 4) = acc[ai][1][m][0]; }
                } else if (pn < 10) {
                    const f32x4 a0 = acc[ai][0][m][0], a1 = acc[ai][0][m][1], g0 = acc[ai][1][m][0], g1 = acc[ai][1][m][1];
                    const f32x4 u0 = (f32x4){a0[0] * sigm_f(g0[0]), a0[1] * sigm_f(g0[1]), a0[2] * sigm_f(g0[2]), a0[3] * sigm_f(g0[3])};
                    const f32x4 u1 = (f32x4){a1[0] * sigm_f(g1[0]), a1[1] * sigm_f(g1[1]), a1[2] * sigm_f(g1[2]), a1[3] * sigm_f(g1[3])};
                    store8(o.Ub + row * 512 + (pn - 6) * 128 + cb, u0, u1);
                } else {
#pragma unroll
                    for (int bj = 0; bj < 2; ++bj) store8(o.GCb + row * 512 + (pn - 10) * 256 + bj * HALF + cb, silu4(acc[ai][bj][m][0]), silu4(acc[ai][bj][m][1]));
                }
            }
    }
};

struct EpiPw2 {
    static constexpr bool PERM = true, AFTER_DRAIN = false;
    const float* bias; const bf16_t* GCb; bf16_t* Y;
    __device__ __forceinline__ void operator()(const f32x4 (&acc)[2][2][4][2], const Unit& u, int wr, int wc, int fr, int fq) const {
        const int row0 = u.pm * BM + wr * 64 + fr, col0 = u.pn * BM + wc * 32 + 8 * fq;
        f32x4 bv[2][2];
#pragma unroll
        for (int bj = 0; bj < 2; ++bj)
#pragma unroll
            for (int n = 0; n < 2; ++n) bv[bj][n] = *(const f32x4*)(bias + col0 + bj * HALF + 4 * n);
#pragma unroll
        for (int ai = 0; ai < 2; ++ai)
#pragma unroll
            for (int m = 0; m < 4; ++m) { const size_t row = (size_t)(row0 + ai * HALF + m * 16);
#pragma unroll
                for (int bj = 0; bj < 2; ++bj) { const int c = col0 + bj * HALF; const u32x4 gc = *(const u32x4*)(GCb + row * 512 + c);
                    f32x4 v0 = acc[ai][bj][m][0] + bv[bj][0], v1 = acc[ai][bj][m][1] + bv[bj][1];
                    v0 = v0 * (f32x4){bflo(gc.x), bfhi(gc.x), bflo(gc.y), bfhi(gc.y)}; v1 = v1 * (f32x4){bflo(gc.z), bfhi(gc.z), bflo(gc.w), bfhi(gc.w)};
                    store8(Y + row * 1024 + 512 + c, v0, v1); } }
    }
};
template <class Epi, class Sched, bool ALIGN_EPI = false, bool SP2 = false>
__device__ __forceinline__ void gemm_phase(PG8_LAS unsigned char* lds, const Gemm g, const Sched& S, const Epi& E) {
    const int tid = threadIdx.x, wid = __builtin_amdgcn_readfirstlane(tid >> 6), lane = tid & 63, wr = wid >> 2, wc = wid & 3, fr = lane & 15, fq = lane >> 4;
    const int K = g.K, nt = K / BK;
    unsigned voffA[2], voffB[2];
#pragma unroll
    for (int i = 0; i < 2; ++i) { int R, C; stage_rc(tid * 16 + i * 8192, R, C); const int Rb = Epi::PERM ? ((R & ~31) + perm32(R & 31)) : R;
        voffA[i] = (unsigned)(R * K + C) * 2u; voffB[i] = (unsigned)(Rb * K + C) * 2u; }
    const size_t kstep = (size_t)(BK * 2);
    const size_t hstep = (size_t)HALF * K * 2;
    const size_t tstep = 2 * hstep;
    const unsigned ldsw = (unsigned)wid * 1024u;
    const int aoff = lds_byte(wr * 64 + fr, fq * 8), boff = lds_byte(wc * 32 + fr, fq * 8);
#define PG8_SA(b, h) (((b) * 2 + (h)) * HTB)
#define PG8_SB(b, h) ((4 + (b) * 2 + (h)) * HTB)
#define PG8_STAGE(bufoff, gbase, voff) do { _Pragma("unroll") for (int _i = 0; _i < 2; ++_i) \
        __builtin_amdgcn_global_load_lds((const unsigned*)((const char*)(gbase) + (voff)[_i]), (PG8_LAS unsigned*)(lds + (bufoff) + ldsw + _i * 8192), 16, 0, 0); } while (0)
#define PG8_LDA(dst, b, h) do { _Pragma("unroll") for (int m = 0; m < 4; ++m) _Pragma("unroll") for (int k = 0; k < 2; ++k) dst[m][k] = *(const PG8_LAS bf16x8*)(lds + PG8_SA(b, h) + aoff + m * 2048 + k * 1024); } while (0)
#define PG8_LDB(dst, b, h) do { _Pragma("unroll") for (int n = 0; n < 2; ++n) _Pragma("unroll") for (int k = 0; k < 2; ++k) dst[n][k] = *(const PG8_LAS bf16x8*)(lds + PG8_SB(b, h) + boff + n * 2048 + k * 1024); } while (0)
#define PG8_MMA(ai, bj, At, Bt) do { __builtin_amdgcn_s_setprio(1); _Pragma("unroll") for (int m = 0; m < 4; ++m) _Pragma("unroll") for (int n = 0; n < 2; ++n) _Pragma("unroll") for (int k = 0; k < 2; ++k) \
        acc[ai][bj][m][n] = __builtin_amdgcn_mfma_f32_16x16x32_bf16(Bt[n][k], At[m][k], acc[ai][bj][m][n], 0, 0, 0); __builtin_amdgcn_s_setprio(0); } while (0)
#define PG8_WAIT_V(n) asm volatile("s_waitcnt vmcnt(" #n ")" ::: "memory")
#define PG8_WAIT_L(n) asm volatile("s_waitcnt lgkmcnt(" #n ")" ::: "memory")
#define PG8_BAR __builtin_amdgcn_s_barrier()
#define PG8_SCHED __builtin_amdgcn_sched_barrier(0)
    Unit cur, nxt; int ui = 0;
    if (!S.next(0, cur)) return;
    f32x4 acc[2][2][4][2];
#pragma unroll
    for (int a = 0; a < 2; ++a)
#pragma unroll
        for (int b = 0; b < 2; ++b)
#pragma unroll
            for (int m = 0; m < 4; ++m)
#pragma unroll
                for (int n = 0; n < 2; ++n) acc[a][b][m][n] = (f32x4){0.f, 0.f, 0.f, 0.f};
    bf16x8 At[4][2], B0[2][2], B1[2][2];
    const char* cA = (const char*)g.A + (size_t)cur.pm * tstep; const char* cB = (const char*)g.Bt + (size_t)cur.pn * tstep;
    S.a_ready(cur);
    if constexpr (SP2) {
        PG8_STAGE(PG8_SB(0, 0), cB, voffB); PG8_STAGE(PG8_SB(0, 1), cB + hstep, voffB); PG8_STAGE(PG8_SA(0, 0), cA, voffA); PG8_STAGE(PG8_SA(0, 1), cA + hstep, voffA);
        if (wr == 1) PG8_BAR;
        PG8_WAIT_V(2); PG8_BAR;
        PG8_STAGE(PG8_SB(1, 0), cB + kstep, voffB); PG8_STAGE(PG8_SA(1, 0), cA + kstep, voffA); PG8_STAGE(PG8_SB(1, 1), cB + hstep + kstep, voffB);
        PG8_WAIT_V(6); PG8_BAR;
    } else {
        PG8_STAGE(PG8_SB(0, 0), cB, voffB); PG8_STAGE(PG8_SA(0, 0), cA, voffA); PG8_STAGE(PG8_SB(0, 1), cB + hstep, voffB); PG8_STAGE(PG8_SA(0, 1), cA + hstep, voffA);
        if (wr == 1) PG8_BAR;
        PG8_WAIT_V(4); PG8_BAR;
        PG8_STAGE(PG8_SB(1, 0), cB + kstep, voffB); PG8_STAGE(PG8_SA(1, 0), cA + kstep, voffA); PG8_STAGE(PG8_SB(1, 1), cB + hstep + kstep, voffB);
        PG8_WAIT_V(6); PG8_BAR;
    }
    for (;;) {
        const bool has_next = S.next(ui + 1, nxt);
        const char* nA = has_next ? (const char*)g.A + (size_t)nxt.pm * tstep : cA; const char* nB = has_next ? (const char*)g.Bt + (size_t)nxt.pn * tstep : cB;
        for (int t = 0; t < nt; t += 2) {
            const bool last = (t == nt - 2);
            const char* a1 = cA + (size_t)(t + 1) * kstep;
            const char* a2 = last ? nA : cA + (size_t)(t + 2) * kstep; const char* b2 = last ? nB : cB + (size_t)(t + 2) * kstep;
            const char* a3 = a2 + kstep; const char* b3 = b2 + kstep;
            if (last && has_next) S.a_ready(nxt);
            if constexpr (SP2) {
            PG8_LDB(B0, 0, 0); PG8_LDB(B1, 0, 1); PG8_SCHED; PG8_LDA(At, 0, 0); PG8_STAGE(PG8_SA(1, 1), a1 + hstep, voffA);
            PG8_WAIT_V(8); PG8_WAIT_L(0); PG8_BAR; PG8_MMA(0, 0, At, B0); PG8_MMA(0, 1, At, B1); PG8_BAR; PG8_SCHED;
            PG8_LDA(At, 0, 1); PG8_STAGE(PG8_SB(0, 0), b2, voffB); PG8_STAGE(PG8_SB(0, 1), b2 + hstep, voffB); PG8_STAGE(PG8_SA(0, 0), a2, voffA);
            PG8_WAIT_V(8); PG8_WAIT_L(0); PG8_BAR; PG8_MMA(1, 0, At, B0); PG8_MMA(1, 1, At, B1); PG8_BAR; PG8_SCHED;
            PG8_LDB(B0, 1, 0); PG8_LDB(B1, 1, 1); PG8_SCHED; PG8_LDA(At, 1, 0); PG8_STAGE(PG8_SA(0, 1), a2 + hstep, voffA);
            PG8_WAIT_V(8); PG8_WAIT_L(0); PG8_BAR; PG8_MMA(0, 0, At, B0); PG8_MMA(0, 1, At, B1); PG8_BAR; PG8_SCHED;
            PG8_LDA(At, 1, 1); PG8_STAGE(PG8_SB(1, 0), b3, voffB); PG8_STAGE(PG8_SB(1, 1), b3 + hstep, voffB); PG8_STAGE(PG8_SA(1, 0), a3, voffA);
            PG8_WAIT_V(8); PG8_WAIT_L(0); PG8_BAR; PG8_MMA(1, 0, At, B0); PG8_MMA(1, 1, At, B1); PG8_BAR; PG8_SCHED;
            } else {
            PG8_LDB(B0, 0, 0); PG8_SCHED; PG8_LDA(At, 0, 0); PG8_STAGE(PG8_SA(1, 1), a1 + hstep, voffA);
            PG8_WAIT_L(8); PG8_BAR; PG8_WAIT_L(0); PG8_MMA(0, 0, At, B0); PG8_BAR; PG8_SCHED;
            PG8_LDB(B1, 0, 1); PG8_STAGE(PG8_SB(0, 0), b2, voffB);
            PG8_BAR; PG8_WAIT_L(0); PG8_MMA(0, 1, At, B1); PG8_BAR;
            PG8_LDA(At, 0, 1); PG8_STAGE(PG8_SA(0, 0), a2, voffA);
            PG8_BAR; PG8_WAIT_L(0); PG8_MMA(1, 0, At, B0); PG8_BAR; PG8_SCHED;
            PG8_STAGE(PG8_SB(0, 1), b2 + hstep, voffB);
            PG8_WAIT_V(6); PG8_BAR; PG8_MMA(1, 1, At, B1); PG8_BAR;
            PG8_LDB(B0, 1, 0); PG8_SCHED; PG8_LDA(At, 1, 0); PG8_STAGE(PG8_SA(0, 1), a2 + hstep, voffA);
            PG8_WAIT_L(8); PG8_BAR; PG8_WAIT_L(0); PG8_MMA(0, 0, At, B0); PG8_BAR; PG8_SCHED;
            PG8_LDB(B1, 1, 1); PG8_STAGE(PG8_SB(1, 0), b3, voffB);
            PG8_BAR; PG8_WAIT_L(0); PG8_MMA(0, 1, At, B1); PG8_BAR;
            PG8_LDA(At, 1, 1); PG8_STAGE(PG8_SA(1, 0), a3, voffA);
            PG8_BAR; PG8_WAIT_L(0); PG8_MMA(1, 0, At, B0); PG8_BAR; PG8_SCHED;
            PG8_STAGE(PG8_SB(1, 1), b3 + hstep, voffB);
            PG8_WAIT_V(6); PG8_BAR; PG8_MMA(1, 1, At, B1); PG8_BAR;
            }
        }
        if constexpr (ALIGN_EPI) { if (wr == 0) PG8_BAR; }
        if constexpr (!Epi::AFTER_DRAIN) { E(acc, cur, wr, wc, fr, fq); S.done(cur); }
        if (!has_next) break;
#pragma unroll
        for (int a = 0; a < 2; ++a)
#pragma unroll
            for (int b = 0; b < 2; ++b)
#pragma unroll
                for (int m = 0; m < 4; ++m)
#pragma unroll
                    for (int n = 0; n < 2; ++n) acc[a][b][m][n] = (f32x4){0.f, 0.f, 0.f, 0.f};
        cur = nxt; cA = nA; cB = nB; ++ui;
        if constexpr (ALIGN_EPI) { if (wr == 1) PG8_BAR; }
    }
    PG8_WAIT_V(0);
    if constexpr (!ALIGN_EPI) { if (wr == 0) PG8_BAR; }
    PG8_BAR;
    if constexpr (Epi::AFTER_DRAIN) { E.fused(acc, cur, wr, wc, fr, fq, lds, wid, lane); S.done(cur); }
#undef PG8_SA
#undef PG8_SB
#undef PG8_STAGE
#undef PG8_LDA
#undef PG8_LDB
#undef PG8_MMA
#undef PG8_WAIT_V
#undef PG8_WAIT_L
#undef PG8_BAR
#undef PG8_SCHED
}
}

#ifndef PG8_SP2
#define PG8_SP2 true
#endif
#ifndef PG8_ALIGN
#define PG8_ALIGN true
#endif
#define GAS __attribute__((address_space(1)))
#define LAS __attribute__((address_space(3)))
typedef unsigned short bf16;
typedef unsigned v4u __attribute__((ext_vector_type(4)));
typedef unsigned v2u __attribute__((ext_vector_type(2)));
typedef float f32x4 __attribute__((ext_vector_type(4)));
typedef short bf16x8 __attribute__((ext_vector_type(8)));
typedef GAS unsigned gu32;
typedef GAS unsigned long long gu64;
#define RLX_AGENT __ATOMIC_RELAXED, __HIP_MEMORY_SCOPE_AGENT
#define LDS_WAIT() asm volatile("s_waitcnt lgkmcnt(0)" ::: "memory")
#define VM_WAIT() asm volatile("s_waitcnt vmcnt(0)" ::: "memory")
__device__ __forceinline__ unsigned f2bf(float f) { unsigned u = __builtin_bit_cast(unsigned, f); return (u + 0x7fffu + ((u >> 16) & 1u)) >> 16; }
__device__ __forceinline__ unsigned pk2(float lo, float hi) { return f2bf(lo) | (f2bf(hi) << 16); }
__device__ __forceinline__ float bf2f(bf16 b) { return __uint_as_float(((unsigned)b) << 16); }
__device__ __forceinline__ float wave_sum(float v) {
#pragma unroll
    for (int o = 1; o < 64; o <<= 1) v += __shfl_xor(v, o);
    return v;
}
__device__ __forceinline__ float wave_max(float v) {
#pragma unroll
    for (int o = 1; o < 64; o <<= 1) v = fmaxf(v, __shfl_xor(v, o));
    return v;
}
#define XB_TMO      128
#define XB_XCNT(j)  (256  + 64 * (j))
#define XB_XSUB(j)  (1280 + 64 * (j))
#define XB_XGEN(j)  (2304 + 64 * (j))
#define XB_TOP      3328
#define XB_TOPGEN   3392
#define XCD_BAR_WORDS 3456
#define XB_SPIN_CAP (1u << 18)

__device__ __forceinline__ unsigned xb_ld(unsigned* p)              { return __hip_atomic_load(p, __ATOMIC_RELAXED, __HIP_MEMORY_SCOPE_AGENT); }
__device__ __forceinline__ unsigned xb_add(unsigned* p, unsigned v) { return __hip_atomic_fetch_add(p, v, __ATOMIC_RELAXED, __HIP_MEMORY_SCOPE_AGENT); }
__device__ __forceinline__ unsigned xb_xcc_id() { return (unsigned)__builtin_amdgcn_s_getreg((3 << 11) | 20) & 0xFu; }
#define XB_SPIN(cond, bar) do { unsigned _sp = 0; while (cond) { __builtin_amdgcn_s_sleep(1); \
    if ((++_sp & 255u) == 0u) { if (xb_ld(&(bar)[XB_TMO])) break; if (_sp > XB_SPIN_CAP) { atomicAdd(&(bar)[XB_TMO], 1u); break; } } } } while (0)

struct XcdBarrier {
    unsigned* bar; unsigned x;
    volatile LAS unsigned* st;
};

__device__ __forceinline__ XcdBarrier xcd_barrier_post(unsigned* bar, volatile LAS unsigned* st) {
    XcdBarrier b; b.bar = bar; b.x = xb_xcc_id(); b.st = st;
    if (threadIdx.x == 0) (void)xb_add(&bar[XB_XCNT(b.x)], 1u);
    return b;
}
__device__ __forceinline__ void xcd_barrier_complete(unsigned* bar, unsigned x, unsigned& nloc, unsigned& nx) {
    const unsigned G = gridDim.x * gridDim.y * gridDim.z;
    unsigned sum, cnt, mine, sp = 0u;
    for (;;) {
        sum = 0u; cnt = 0u; mine = 0u;
#pragma unroll
        for (unsigned j = 0; j < 16; ++j) { const unsigned c = xb_ld(&bar[XB_XCNT(j)]); sum += c; cnt += (c > 0u) ? 1u : 0u; mine = (j == x) ? c : mine; }
        if (sum == G) break;
        __builtin_amdgcn_s_sleep(1);
        if ((++sp & 255u) == 0u) { if (xb_ld(&bar[XB_TMO])) break; if (sp > XB_SPIN_CAP) { atomicAdd(&bar[XB_TMO], 1u); break; } }
    }
    nloc = mine > 0u ? mine : 1u; nx = cnt > 0u ? cnt : 1u;
}

__device__ __forceinline__ void xcd_barrier(const XcdBarrier& b) {
    asm volatile("s_waitcnt vmcnt(0)" ::: "memory");
    __syncthreads();
    if (threadIdx.x == 0) {
        unsigned* bar = b.bar;
        __builtin_amdgcn_s_waitcnt(0);
        unsigned nloc = b.st[0], nx = b.st[1];
        if (nloc == 0u) { xcd_barrier_complete(bar, b.x, nloc, nx); b.st[0] = nloc; b.st[1] = nx; }
        const unsigned old = xb_add(&bar[XB_XSUB(b.x)], 1u);
        const unsigned gen = old / nloc;
        if (old + 1u == (gen + 1u) * nloc) {
            __builtin_amdgcn_fence(__ATOMIC_RELEASE, "agent");
            asm volatile("s_waitcnt vmcnt(0)" ::: "memory");
            const unsigned og = xb_add(&bar[XB_TOP], 1u);
            const unsigned tg = og / nx;
            if (og + 1u == (tg + 1u) * nx) xb_add(&bar[XB_TOPGEN], 1u);
            else XB_SPIN(xb_ld(&bar[XB_TOPGEN]) == tg, bar);
            __builtin_amdgcn_fence(__ATOMIC_ACQUIRE, "agent");
            xb_add(&bar[XB_XGEN(b.x)], 1u);
            asm volatile("s_waitcnt vmcnt(0)" ::: "memory");
        } else {
            XB_SPIN(xb_ld(&bar[XB_XGEN(b.x)]) == gen, bar);
            __builtin_amdgcn_fence(__ATOMIC_ACQUIRE, "agent");
            asm volatile("s_waitcnt vmcnt(0)" ::: "memory");
        }
    }
    __syncthreads();
}

constexpr int NWAVES = 8;
#ifndef MK_N_LAUNCHES
#define MK_N_LAUNCHES 7
#endif
constexpr int NPHASE = 7;
constexpr int N_LAUNCHES = MK_N_LAUNCHES;
static_assert(N_LAUNCHES == 1 || N_LAUNCHES == NPHASE, "MK_N_LAUNCHES is 1 or 7");
constexpr int BATCH = 8, SEQ = 2048, D = 1024, M = BATCH * SEQ;
constexpr int NIN = 3072, NIN_ORIG = 3012, DH = 512;
constexpr int CONVW = 31, TOPK = 256;
constexpr float EPS = 1e-6f;
constexpr float C2 = 0.125f * 1.4426950408889634f;

constexpr size_t MiB = 1u << 20;
constexpr size_t WS_CTL = 0, CTL_ZERO_BYTES = 1 * MiB;
constexpr size_t WS_MOD = 1 * MiB;
constexpr size_t WS_WIN = 2 * MiB;
constexpr size_t WS_WPW = 8 * MiB;
constexpr size_t WS_WOUT = 9 * MiB;
constexpr size_t WS_X = 11 * MiB;
constexpr size_t WS_HB = 16 * MiB;
constexpr size_t WS_QB = 48 * MiB;
constexpr size_t WS_GAB = 64 * MiB;
constexpr size_t WS_QIB = 80 * MiB;
constexpr size_t WS_KB = 88 * MiB, WS_VB = 90 * MiB, WS_KIB = 92 * MiB;
constexpr size_t WS_WI = 94 * MiB;
constexpr size_t WS_UB = 96 * MiB;
constexpr size_t WS_GCB = 112 * MiB;
constexpr size_t WS_A2B = 128 * MiB;
constexpr size_t WS_YCAT = 144 * MiB;
constexpr size_t WS_YF = 176 * MiB;
constexpr size_t WS_END = 240 * MiB;
constexpr int CW_TMO = 0, CW_CODE = 1, CW_BAR = 4096, CW_SEAM = 16384;

constexpr int RING_OFF = 0, RING_BYTES = 131072;
constexpr int LDSCTL_OFF = RING_BYTES, MISC_OFF = LDSCTL_OFF + 320;
constexpr int LDS_BYTES = 147456;

__host__ __device__ __forceinline__ int win_orig_col(int n) {
    const int pn = n >> 8, c = n & 255;
    if (pn < 2) return n;
    if (pn < 4) return 640 + (n - 512);
    if (pn == 4) return 1152 + c;
    if (pn == 5) { if (c < 64) return 512 + c; if (c < 128) return 576 + (c - 64); if (c < 192) return 1408 + (c - 128); if (c < 196) return 1472 + (c - 192); return -1; }
    if (pn < 10) { const int j = pn - 6; return c < 128 ? 1476 + 128 * j + c : 1988 + 128 * j + (c - 128); }
    return 2500 + (n - 2560);
}

struct Frame {
    LAS unsigned char* lds;
    volatile LAS unsigned* MISC;
    gu32* ctl;
    int tid, lane, wave, vcu, G;
    const float *x, *c, *w_ada, *b_ada, *g_pre, *w_in, *w_dw, *b_dw, *g_cn, *b_cn, *w_pw2, *b_pw2, *w_out, *g_post;
    float* out;
    float *MOD, *WI, *YF;
    bf16 *WIN, *WPW, *WOUT, *HB, *QB, *GAB, *QIB, *KB, *VB, *KIB, *UB, *GCB, *A2B, *YCAT;
};

template <bool MAPPED>
__device__ __forceinline__ void p0_transpose_item(const float* W, int K, int ldw, bf16* WT, LAS float* scr, int item, int nblk, int lane) {
    const int kb = item / nblk, nb = item % nblk, k0 = 64 * kb, n0 = 32 * nb;
    const int oc = MAPPED ? win_orig_col(n0 + (lane & 31)) : (n0 + (lane & 31));
#pragma unroll 8
    for (int i = 0; i < 32; ++i) { const int kk = 2 * i + (lane >> 5); scr[kk * 33 + (lane & 31)] = (oc >= 0) ? W[(size_t)(k0 + kk) * ldw + oc] : 0.f; }
    LDS_WAIT(); asm volatile("" ::: "memory");
    const int c = lane & 7;
#pragma unroll
    for (int j = 0; j < 4; ++j) { const int n = (lane >> 3) + 8 * j; const LAS float* s = scr + (8 * c) * 33 + n;
        v4u o; o.x = pk2(s[0 * 33], s[1 * 33]); o.y = pk2(s[2 * 33], s[3 * 33]); o.z = pk2(s[4 * 33], s[5 * 33]); o.w = pk2(s[6 * 33], s[7 * 33]);
        *(GAS v4u*)(WT + (size_t)(n0 + n) * K + k0 + 8 * c) = o; }
    LDS_WAIT(); asm volatile("" ::: "memory");
}
__device__ __forceinline__ float silu_d(float x) { return x / (1.0f + __expf(-x)); }

__device__ __forceinline__ void p0_prologue(Frame& F) {
    LAS float* scr = (LAS float*)(F.lds + RING_OFF + F.wave * 16384);
    const int gw = F.vcu * NWAVES + F.wave, NGW = F.G * NWAVES;
    constexpr int I_IN = (D / 64) * (NIN / 32), I_PW = (DH / 64) * (DH / 32), I_OUT = (D / 64) * (D / 32);
    constexpr int NITEMS = I_IN + I_PW + I_OUT;
    for (int it = gw; it < NITEMS; it += NGW) {
        int r = it;
        if (r < I_IN) { p0_transpose_item<true>(F.w_in, D, NIN_ORIG, F.WIN, scr, r, NIN / 32, F.lane); continue; } r -= I_IN;
        if (r < I_PW) { p0_transpose_item<false>(F.w_pw2, DH, DH, F.WPW, scr, r, DH / 32, F.lane); continue; } r -= I_PW;
        p0_transpose_item<false>(F.w_out, D, D, F.WOUT, scr, r, D / 32, F.lane);
    }
    __syncthreads();
    if (F.vcu < 192) {
        LAS float* sc = (LAS float*)(F.lds + RING_OFF);
        LAS float* part = (LAS float*)(F.lds + RING_OFF + 32768);
        for (int i = F.tid; i < BATCH * D; i += NWAVES * 64) sc[i] = silu_d(F.c[i]);
        __syncthreads();
        const int j0 = 16 * F.vcu, c4 = F.tid & 3, kr = F.tid >> 2;
        f32x4 acc[8];
#pragma unroll
        for (int b = 0; b < 8; ++b) acc[b] = (f32x4){0.f, 0.f, 0.f, 0.f};
#pragma unroll
        for (int r = 0; r < 8; ++r) { const int i = kr * 8 + r; const f32x4 w = *(const GAS f32x4*)(F.w_ada + (size_t)i * (3 * D) + j0 + 4 * c4);
#pragma unroll
            for (int b = 0; b < 8; ++b) acc[b] += w * sc[b * D + i]; }
#pragma unroll
        for (int b = 0; b < 8; ++b)
#pragma unroll
            for (int e = 0; e < 4; ++e) { float v = acc[b][e]; v += __shfl_xor(v, 4); v += __shfl_xor(v, 8); v += __shfl_xor(v, 16); v += __shfl_xor(v, 32); acc[b][e] = v; }
        if (F.lane < 4) {
#pragma unroll
            for (int b = 0; b < 8; ++b)
#pragma unroll
                for (int e = 0; e < 4; ++e) part[F.wave * 128 + b * 16 + 4 * F.lane + e] = acc[b][e];
        }
        __syncthreads();
        if (F.tid < 128) { const int b = F.tid >> 4, col = F.tid & 15; float s = F.b_ada[j0 + col];
#pragma unroll
            for (int w = 0; w < 8; ++w) s += part[w * 128 + b * 16 + col];
            F.MOD[b * (3 * D) + j0 + col] = s; }
        __syncthreads();
    }
}

__device__ __forceinline__ void p1_rows(Frame& F) {
    const int gw = F.vcu * NWAVES + F.wave, NGW = F.G * NWAVES;
    for (int m = gw; m < M; m += NGW) {
        const int b = m / SEQ;
        const GAS f32x4* xr = (const GAS f32x4*)(F.x + (size_t)m * D) + F.lane;
        f32x4 v[4]; float s = 0.f;
#pragma unroll
        for (int j = 0; j < 4; ++j) { v[j] = xr[64 * j]; s += (v[j].x * v[j].x + v[j].y * v[j].y) + (v[j].z * v[j].z + v[j].w * v[j].w); }
        const float rstd = 1.0f / sqrtf(wave_sum(s) * (1.f / D) + EPS);
        GAS unsigned long long* o8 = (GAS unsigned long long*)(F.HB + (size_t)m * D) + F.lane;
#pragma unroll
        for (int j = 0; j < 4; ++j) { const int col = 4 * (F.lane + 64 * j);
            const f32x4 g = *(const GAS f32x4*)(F.g_pre + col), sh = *(const GAS f32x4*)(F.MOD + b * (3 * D) + col), scl = *(const GAS f32x4*)(F.MOD + b * (3 * D) + D + col);
            const f32x4 h = v[j] * rstd * g * (scl + 1.0f) + sh;
            o8[64 * j] = (unsigned long long)pk2(h.x, h.y) | ((unsigned long long)pk2(h.z, h.w) << 32); }
    }
}

__device__ __forceinline__ unsigned fkey(float f) { f += 0.0f; const unsigned u = __float_as_uint(f); return (u & 0x80000000u) ? ~u : (u | 0x80000000u); }
__device__ __forceinline__ int wave_cnt(bool p) { return __popcll(__ballot(p)); }
__device__ __forceinline__ int lane_prefix(bool p, int lane) { const unsigned long long m = __ballot(p); return __popcll(m & ((1ull << lane) - 1ull)); }

__device__ __forceinline__ void attn_naive_unit(Frame& F, int row) {
    LAS float* qi = (LAS float*)(F.lds + RING_OFF);
    LAS float* qh = (LAS float*)(F.lds + RING_OFF + 1024);
    LAS int* selidx = (LAS int*)(F.lds + RING_OFF + 3072);
    LAS int* red = (LAS int*)(F.lds + RING_OFF + 4096);
    LAS float* pb = (LAS float*)(F.lds + RING_OFF + 8192);
    const int b = row / SEQ, t = row % SEQ, n = t + 1, tid = F.tid, lane = F.lane, wave = F.wave;
    if (tid < 256) qi[tid] = bf2f(F.QIB[(size_t)row * 256 + tid]);
    qh[tid] = bf2f(F.QB[(size_t)row * 512 + tid]);
    const f32x4 wv = *(const GAS f32x4*)(F.WI + (size_t)row * 4);
    __syncthreads();
    unsigned key[4]; bool sel[4]; int pos[4];
#pragma unroll
    for (int j = 0; j < 4; ++j) {
        const int s = wave * 256 + 64 * j + lane; key[j] = 0u;
        if (s <= t) {
            const GAS v4u* kr = (const GAS v4u*)(F.KIB + ((size_t)b * SEQ + s) * 64);
            float l0 = 0.f, l1 = 0.f, l2 = 0.f, l3 = 0.f;
#pragma unroll
            for (int c = 0; c < 8; ++c) { const v4u kv = kr[c]; const unsigned kw[4] = {kv.x, kv.y, kv.z, kv.w};
#pragma unroll
                for (int e = 0; e < 4; ++e) { const float k0 = __uint_as_float(kw[e] << 16), k1 = __uint_as_float(kw[e] & 0xffff0000u); const int d = 8 * c + 2 * e;
                    l0 += qi[d] * k0 + qi[d + 1] * k1; l1 += qi[64 + d] * k0 + qi[64 + d + 1] * k1; l2 += qi[128 + d] * k0 + qi[128 + d + 1] * k1; l3 += qi[192 + d] * k0 + qi[192 + d + 1] * k1; } }
            const float scv = wv.x * fmaxf(l0, 0.f) + wv.y * fmaxf(l1, 0.f) + wv.z * fmaxf(l2, 0.f) + wv.w * fmaxf(l3, 0.f);
            key[j] = fkey(scv);
        }
    }
    int nsel;
    if (n <= TOPK) {
        nsel = n;
#pragma unroll
        for (int j = 0; j < 4; ++j) { const int s = wave * 256 + 64 * j + lane; sel[j] = (s <= t); pos[j] = s; }
    } else {
        nsel = TOPK;
        unsigned T = 0u;
        for (int bit = 31; bit >= 0; --bit) {
            const unsigned cand = T | (1u << bit);
            int c = 0;
#pragma unroll
            for (int j = 0; j < 4; ++j) c += wave_cnt(key[j] >= cand);
            if (lane == 0) red[(bit & 1) * 8 + wave] = c;
            __syncthreads();
            int tot = 0;
#pragma unroll
            for (int w = 0; w < 8; ++w) tot += red[(bit & 1) * 8 + w];
            if (tot >= TOPK) T = cand;
        }
        int cg = 0, ce = 0;
#pragma unroll
        for (int j = 0; j < 4; ++j) { cg += wave_cnt(key[j] > T); ce += wave_cnt(key[j] == T); }
        if (lane == 0) { red[16 + wave] = cg; red[24 + wave] = ce; }
        __syncthreads();
        int totg = 0, base_eq = 0;
#pragma unroll
        for (int w = 0; w < 8; ++w) { totg += red[16 + w]; if (w < wave) base_eq += red[24 + w]; }
        const int r = TOPK - totg;
        int run = base_eq, cs = 0;
#pragma unroll
        for (int j = 0; j < 4; ++j) { const bool eq = (key[j] == T); const int my = run + lane_prefix(eq, lane); sel[j] = (key[j] > T) || (eq && my < r); run += wave_cnt(eq); cs += wave_cnt(sel[j]); }
        if (lane == 0) red[32 + wave] = cs;
        __syncthreads();
        int base = 0;
#pragma unroll
        for (int w = 0; w < 8; ++w) if (w < wave) base += red[32 + w];
        run = base;
#pragma unroll
        for (int j = 0; j < 4; ++j) { pos[j] = run + lane_prefix(sel[j], lane); run += wave_cnt(sel[j]); }
    }
#pragma unroll
    for (int j = 0; j < 4; ++j) if (sel[j]) selidx[pos[j]] = wave * 256 + 64 * j + lane;
    __syncthreads();
    const float slope2 = exp2f(-(float)(wave + 1)) * 1.4426950408889634f;
    float sv[4]; float mx = -INFINITY;
#pragma unroll
    for (int j = 0; j < 4; ++j) { const int i = lane + 64 * j; sv[j] = -INFINITY;
        if (i < nsel) { const int s = selidx[i]; const GAS v4u* kr = (const GAS v4u*)(F.KB + ((size_t)b * SEQ + s) * 64); float dot = 0.f;
#pragma unroll
            for (int c = 0; c < 8; ++c) { const v4u kv = kr[c]; const unsigned kw[4] = {kv.x, kv.y, kv.z, kv.w};
#pragma unroll
                for (int e = 0; e < 4; ++e) { const int d = wave * 64 + 8 * c + 2 * e; dot += qh[d] * __uint_as_float(kw[e] << 16) + qh[d + 1] * __uint_as_float(kw[e] & 0xffff0000u); } }
            sv[j] = dot - slope2 * (float)(t - s); }
        mx = fmaxf(mx, sv[j]); }
    mx = wave_max(mx);
    float l = 0.f;
#pragma unroll
    for (int j = 0; j < 4; ++j) { const int i = lane + 64 * j; const float p = (i < nsel) ? exp2f(sv[j] - mx) : 0.f; pb[wave * 256 + i] = p; l += p; }
    l = wave_sum(l);
    __syncthreads();
    float o = 0.f;
    for (int ii = 0; ii < nsel; ++ii) { const int s = selidx[ii]; o += pb[wave * 256 + ii] * bf2f(F.VB[((size_t)b * SEQ + s) * 64 + lane]); }
    o = o / l;
    const float ga = bf2f(F.GAB[(size_t)row * 512 + wave * 64 + lane]);
    F.YCAT[(size_t)row * 1024 + wave * 64 + lane] = (bf16)f2bf(o * ga);
    __syncthreads();
}

__device__ __forceinline__ void conv_naive_unit(Frame& F, int row) {
    LAS float* red = (LAS float*)(F.lds + RING_OFF);
    const int b = row / SEQ, t = row % SEQ, c = F.tid;
    float acc = F.b_dw[c];
    for (int j = 0; j < CONVW; ++j) { const int tt = t - (CONVW - 1) + j; if (tt >= 0) acc += F.w_dw[j * DH + c] * bf2f(F.UB[((size_t)b * SEQ + tt) * DH + c]); }
    const float s = wave_sum(acc);
    if (F.lane == 0) red[F.wave] = s;
    __syncthreads();
    float mean = 0.f;
#pragma unroll
    for (int w = 0; w < 8; ++w) mean += red[w];
    mean *= (1.f / DH);
    const float d = acc - mean; const float q = wave_sum(d * d);
    if (F.lane == 0) red[8 + F.wave] = q;
    __syncthreads();
    float var = 0.f;
#pragma unroll
    for (int w = 0; w < 8; ++w) var += red[8 + w];
    var *= (1.f / DH);
    float y = d * (1.0f / sqrtf(var + EPS)) * F.g_cn[c] + F.b_cn[c];
    y = silu_d(y);
    F.A2B[(size_t)row * DH + c] = (bf16)f2bf(y);
    __syncthreads();
}

__device__ __forceinline__ void p6_rows(Frame& F) {
    const int gw = F.vcu * NWAVES + F.wave, NGW = F.G * NWAVES;
    for (int m = gw; m < M; m += NGW) {
        const int b = m / SEQ;
        const GAS f32x4* yr = (const GAS f32x4*)(F.YF + (size_t)m * D) + F.lane;
        const GAS f32x4* xr = (const GAS f32x4*)(F.x + (size_t)m * D) + F.lane;
        GAS f32x4* orow = (GAS f32x4*)(F.out + (size_t)m * D) + F.lane;
        f32x4 v[4]; float s = 0.f;
#pragma unroll
        for (int j = 0; j < 4; ++j) { v[j] = yr[64 * j]; s += (v[j].x * v[j].x + v[j].y * v[j].y) + (v[j].z * v[j].z + v[j].w * v[j].w); }
        const float rstd = 1.0f / sqrtf(wave_sum(s) * (1.f / D) + EPS);
#pragma unroll
        for (int j = 0; j < 4; ++j) { const int col = 4 * (F.lane + 64 * j);
            const f32x4 g = *(const GAS f32x4*)(F.g_post + col), gt = *(const GAS f32x4*)(F.MOD + b * (3 * D) + 2 * D + col);
            orow[64 * j] = xr[64 * j] + gt * (v[j] * rstd * g); }
    }
}

struct Args { const float* in[14]; float* out; unsigned char* ws; int ph_lo, ph_hi, li, pad; };
__global__ void __launch_bounds__(NWAVES * 64, 2) fwd_kernel(Args args) {
    extern __shared__ __attribute__((aligned(16))) unsigned char lds[];
    Frame F;
    F.lds = (LAS unsigned char*)lds;
    F.MISC = (volatile LAS unsigned*)(F.lds + MISC_OFF);
    F.tid = threadIdx.x; F.lane = F.tid & 63; F.wave = __builtin_amdgcn_readfirstlane(F.tid >> 6);
    F.G = gridDim.x; { const int bx = blockIdx.x; F.vcu = (F.G % 8 == 0) ? (bx % 8) * (F.G / 8) + bx / 8 : bx; }
    unsigned char* ws = args.ws;
    F.ctl = (gu32*)(ws + WS_CTL);
    F.x = args.in[0]; F.c = args.in[1]; F.w_ada = args.in[2]; F.b_ada = args.in[3]; F.g_pre = args.in[4]; F.w_in = args.in[5]; F.w_dw = args.in[6]; F.b_dw = args.in[7];
    F.g_cn = args.in[8]; F.b_cn = args.in[9]; F.w_pw2 = args.in[10]; F.b_pw2 = args.in[11]; F.w_out = args.in[12]; F.g_post = args.in[13]; F.out = args.out;
    F.MOD = (float*)(ws + WS_MOD); F.WI = (float*)(ws + WS_WI); F.YF = (float*)(ws + WS_YF);
    F.WIN = (bf16*)(ws + WS_WIN); F.WPW = (bf16*)(ws + WS_WPW); F.WOUT = (bf16*)(ws + WS_WOUT); F.HB = (bf16*)(ws + WS_HB); F.QB = (bf16*)(ws + WS_QB); F.GAB = (bf16*)(ws + WS_GAB);
    F.QIB = (bf16*)(ws + WS_QIB); F.KB = (bf16*)(ws + WS_KB); F.VB = (bf16*)(ws + WS_VB); F.KIB = (bf16*)(ws + WS_KIB); F.UB = (bf16*)(ws + WS_UB); F.GCB = (bf16*)(ws + WS_GCB);
    F.A2B = (bf16*)(ws + WS_A2B); F.YCAT = (bf16*)(ws + WS_YCAT);
    for (int u = F.tid; u < (LDS_BYTES - LDSCTL_OFF) / 4; u += NWAVES * 64) ((LAS unsigned*)(F.lds + LDSCTL_OFF))[u] = 0u;
    __syncthreads();
    XcdBarrier bar; bar.bar = (unsigned*)(F.ctl + CW_BAR); bar.x = 0; bar.st = nullptr;
    if (N_LAUNCHES == 1) bar = xcd_barrier_post((unsigned*)(F.ctl + CW_BAR), F.MISC + 8);
#define GRID_BAR() do { if (N_LAUNCHES == 1) xcd_barrier(bar); } while (0)
    const int lo = args.ph_lo, hi = args.ph_hi;
#define IN(k) (lo <= (k) && (k) < hi)
#define BOTH(k) (IN(k) && IN((k) + 1))

    if (IN(0)) { p0_prologue(F); if (BOTH(0)) GRID_BAR(); }
    if (IN(1)) { p1_rows(F); if (BOTH(1)) GRID_BAR(); }
    if (IN(2)) {
        pg8::Gemm g{F.HB, F.WIN, M, NIN, D}; pg8::StaticOrder S; S.init(M, NIN, F.G, (int)blockIdx.x);
        pg8::EpiInProj E{{F.QB, F.KB, F.VB, F.GAB, F.QIB, F.KIB, F.UB, F.GCB, F.WI}, C2};
        pg8::gemm_phase<pg8::EpiInProj, pg8::StaticOrder, PG8_ALIGN, PG8_SP2>(F.lds + RING_OFF, g, S, E);
        if (BOTH(2)) GRID_BAR();
    }
    if (IN(3)) {
        for (int row = F.vcu; row < M; row += F.G) conv_naive_unit(F, row);
        for (int row = F.vcu; row < M; row += F.G) attn_naive_unit(F, row);
        if (BOTH(3)) GRID_BAR();
    }
    if (IN(4)) {
        pg8::Gemm g{F.A2B, F.WPW, M, DH, DH}; pg8::StaticOrder S; S.init(M, DH, F.G, (int)blockIdx.x);
        pg8::EpiPw2 E{F.b_pw2, F.GCB, F.YCAT};
        pg8::gemm_phase<pg8::EpiPw2, pg8::StaticOrder, PG8_ALIGN, PG8_SP2>(F.lds + RING_OFF, g, S, E);
        if (BOTH(4)) GRID_BAR();
    }
    if (IN(5)) {
        pg8::Gemm g{F.YCAT, F.WOUT, M, D, D}; pg8::StaticOrder S; S.init(M, D, F.G, (int)blockIdx.x);
        pg8::EpiF32 E{F.YF, D};
        pg8::gemm_phase<pg8::EpiF32, pg8::StaticOrder, PG8_ALIGN, PG8_SP2>(F.lds + RING_OFF, g, S, E);
        if (BOTH(5)) GRID_BAR();
    }
    if (IN(6)) { p6_rows(F); }
#undef IN
#undef BOTH
}

extern "C" void kernel_launch(void* const* d_in, const int* in_sizes, int n_in, void* d_out, int out_size, void* d_ws, size_t ws_size, hipStream_t stream) {
    static int grid = 0;
    if (grid == 0) {
        if (n_in != 14 || in_sizes[0] != M * D || out_size != M * D || ws_size < WS_END) { fprintf(stderr, "kernel_launch: unexpected shapes (n_in %d, in0 %d, out %d, ws %zu); nothing launched\n", n_in, n_in > 0 ? in_sizes[0] : -1, out_size, ws_size); grid = -1; return; }
        int dev = 0, cus = 0, per_cu = 0;
        if (hipGetDevice(&dev) != hipSuccess || hipDeviceGetAttribute(&cus, hipDeviceAttributeMultiprocessorCount, dev) != hipSuccess) { fprintf(stderr, "kernel_launch: device query failed\n"); grid = -1; return; }
        if (hipFuncSetAttribute((const void*)fwd_kernel, hipFuncAttributeMaxDynamicSharedMemorySize, LDS_BYTES) != hipSuccess) { fprintf(stderr, "kernel_launch: hipFuncSetAttribute failed\n"); grid = -1; return; }
        if (hipOccupancyMaxActiveBlocksPerMultiprocessor(&per_cu, (const void*)fwd_kernel, NWAVES * 64, LDS_BYTES) != hipSuccess || per_cu < 1)
            fprintf(stderr, "kernel_launch: note: occupancy query reports %d workgroups per CU\n", per_cu);
        (void)hipGetLastError();
        grid = cus;
    }
    if (grid < 0) return;
    if (hipMemsetAsync((char*)d_ws + WS_CTL, 0, CTL_ZERO_BYTES, stream) != hipSuccess) { fprintf(stderr, "kernel_launch: memset failed\n"); return; }
    Args a{};
    for (int i = 0; i < 14; ++i) a.in[i] = (const float*)d_in[i];
    a.out = (float*)d_out; a.ws = (unsigned char*)d_ws;
    for (int li = 0; li < N_LAUNCHES; ++li) {
        a.ph_lo = (N_LAUNCHES == 1) ? 0 : li; a.ph_hi = (N_LAUNCHES == 1) ? NPHASE : li + 1; a.li = li;
        hipLaunchKernelGGL(fwd_kernel, dim3(grid), dim3(NWAVES * 64), LDS_BYTES, stream, a);
        const hipError_t le = hipPeekAtLastError();
        if (le != hipSuccess) { fprintf(stderr, "kernel_launch: launch %d failed: %s\n", li, hipGetErrorName(le)); break; }
    }
}
```

```cpp
#include <hip/hip_runtime.h>
#include <cstdio>
#include <cstdint>
namespace pg8 {
#define PG8_LAS __attribute__((address_space(3)))
typedef unsigned short bf16_t;
typedef short bf16x8 __attribute__((ext_vector_type(8)));
typedef float f32x4 __attribute__((ext_vector_type(4)));
typedef unsigned u32x4 __attribute__((ext_vector_type(4)));
constexpr int BM = 256, BK = 64, HALF = 128, HTB = HALF * BK * 2  , STAGE_BYTES = 8 * HTB, NXCD = 8, WGM = 8;

__host__ __device__ __forceinline__ int lds_byte(int r, int c) { const int st = (r >> 4) * 2 + (c >> 5), rr = r & 15, cc = c & 31, ob = rr * 64 + cc * 2; return st * 1024 + (ob ^ (((ob >> 9) & 1) << 5)); }
__host__ __device__ __forceinline__ void stage_rc(int b, int& R, int& C) { const int st = b / 1024, sb = b % 1024, swz = sb ^ (((sb >> 9) & 1) << 5); R = (st >> 1) * 16 + swz / 64; C = (st & 1) * 32 + (swz % 64) / 2; }
__host__ __device__ __forceinline__ int perm32(int rho) { const int n = rho >> 4, i = rho & 15; return 8 * (i >> 2) + 4 * n + (i & 3); }

struct Unit { int pm, pn; };
struct Gemm { const bf16_t* A; const bf16_t* Bt; int M, N, K; };

struct StaticOrder {
    int nM, nN, nwg, G, c;
    __host__ __device__ void init(int M, int N, int G_, int c_) { nM = M / BM; nN = N / BM; nwg = nM * nN; G = G_; c = c_; }
    __host__ __device__ bool next(int i, Unit& u) const {
        const long L = (long)i * G + c; if (L >= nwg) return false;
        int wgid = (int)L; { const int q = nwg / NXCD, r = nwg % NXCD, xcd = wgid % NXCD, off = wgid / NXCD; wgid = (xcd < r ? xcd * (q + 1) : r * (q + 1) + (xcd - r) * q) + off; }
        const int nig = WGM * nN, gid = wgid / nig, fm = gid * WGM, gsz = (nM - fm) < WGM ? (nM - fm) : WGM;
        u.pm = fm + ((wgid % nig) % gsz); u.pn = (wgid % nig) / gsz; return true;
    }
    __device__ __forceinline__ void a_ready(const Unit&) const {}
    __device__ __forceinline__ void done(const Unit&) const {}
};

__device__ __forceinline__ unsigned cvt_pk_bf16(float lo, float hi) { unsigned r; asm volatile("v_cvt_pk_bf16_f32 %0, %1, %2" : "=v"(r) : "v"(lo), "v"(hi)); return r; }
typedef float f32x2 __attribute__((ext_vector_type(2)));

__device__ __forceinline__ float sigm_f(float x) { return __builtin_amdgcn_rcpf(1.0f + __builtin_amdgcn_exp2f(-1.4426950408889634f * x)); }
__device__ __forceinline__ float silu_f(float x) { return x * sigm_f(x); }
__device__ __forceinline__ f32x4 silu4(f32x4 v) { return (f32x4){silu_f(v[0]), silu_f(v[1]), silu_f(v[2]), silu_f(v[3])}; }
__device__ __forceinline__ void store8(bf16_t* p, f32x4 v0, f32x4 v1) { u32x4 w; w.x = cvt_pk_bf16(v0[0], v0[1]); w.y = cvt_pk_bf16(v0[2], v0[3]); w.z = cvt_pk_bf16(v1[0], v1[1]); w.w = cvt_pk_bf16(v1[2], v1[3]); *(u32x4*)p = w; }
__device__ __forceinline__ float bflo(unsigned w) { return __uint_as_float(w << 16); }
__device__ __forceinline__ float bfhi(unsigned w) { return __uint_as_float(w & 0xffff0000u); }

struct EpiF32 {
    static constexpr bool PERM = false, AFTER_DRAIN = false;
    float* C; int ldc;
    __device__ __forceinline__ void operator()(const f32x4 (&acc)[2][2][4][2], const Unit& u, int wr, int wc, int fr, int fq) const {
        const int row0 = u.pm * BM + wr * 64 + fr, col0 = u.pn * BM + wc * 32 + 4 * fq;
#pragma unroll
        for (int ai = 0; ai < 2; ++ai)
#pragma unroll
            for (int m = 0; m < 4; ++m) { float* rowp = C + (size_t)(row0 + ai * HALF + m * 16) * ldc + col0;
#pragma unroll
                for (int bj = 0; bj < 2; ++bj)
#pragma unroll
                    for (int n = 0; n < 2; ++n) *(f32x4*)(rowp + bj * HALF + n * 16) = acc[ai][bj][m][n]; }
    }
};

struct InProjOut { bf16_t *Qb, *Kb, *Vb, *GAb, *QIb, *KIb, *Ub, *GCb; float* WI; };
struct EpiInProj {
    static constexpr bool PERM = true, AFTER_DRAIN = false;
    InProjOut o; float qscale;
    __device__ __forceinline__ void operator()(const f32x4 (&acc)[2][2][4][2], const Unit& u, int wr, int wc, int fr, int fq) const {
        const int row0 = u.pm * BM + wr * 64 + fr, cb = wc * 32 + 8 * fq, pn = u.pn;
#pragma unroll
        for (int ai = 0; ai < 2; ++ai)
#pragma unroll
            for (int m = 0; m < 4; ++m) {
                const size_t row = (size_t)(row0 + ai * HALF + m * 16);
                if (pn < 2) {
#pragma unroll
                    for (int bj = 0; bj < 2; ++bj) store8(o.Qb + row * 512 + pn * 256 + bj * HALF + cb, acc[ai][bj][m][0] * qscale, acc[ai][bj][m][1] * qscale);
                } else if (pn < 4) {
#pragma unroll
                    for (int bj = 0; bj < 2; ++bj) store8(o.GAb + row * 512 + (pn - 2) * 256 + bj * HALF + cb, silu4(acc[ai][bj][m][0]), silu4(acc[ai][bj][m][1]));
                } else if (pn == 4) {
#pragma unroll
                    for (int bj = 0; bj < 2; ++bj) store8(o.QIb + row * 256 + bj * HALF + cb, acc[ai][bj][m][0], acc[ai][bj][m][1]);
                } else if (pn == 5) {
                    if (wc < 2) { store8(o.Kb + row * 64 + cb, acc[ai][0][m][0], acc[ai][0][m][1]); store8(o.KIb + row * 64 + cb, acc[ai][1][m][0], acc[ai][1][m][1]); }
                    else { store8(o.Vb + row * 64 + (cb - 64), acc[ai][0][m][0], acc[ai][0][m][1]); if (wc == 2 && fq == 0) *(f32x4*)(o.WI + row * 4) = acc[ai][1][m][0]; }
                } else if (pn < 10) {
                    const f32x4 a0 = acc[ai][0][m][0], a1 = acc[ai][0][m][1], g0 = acc[ai][1][m][0], g1 = acc[ai][1][m][1];
                    const f32x4 u0 = (f32x4){a0[0] * sigm_f(g0[0]), a0[1] * sigm_f(g0[1]), a0[2] * sigm_f(g0[2]), a0[3] * sigm_f(g0[3])};
                    const f32x4 u1 = (f32x4){a1[0] * sigm_f(g1[0]), a1[1] * sigm_f(g1[1]), a1[2] * sigm_f(g1[2]), a1[3] * sigm_f(g1[3])};
                    store8(o.Ub + row * 512 + (pn - 6) * 128 + cb, u0, u1);
                } else {
#pragma unroll
                    for (int bj = 0; bj < 2; ++bj) store8(o.GCb + row * 512 + (pn - 10) * 256 + bj * HALF + cb, silu4(acc[ai][bj][m][0]), silu4(acc[ai][bj][m][1]));
                }
            }
    }
};

struct EpiPw2 {
    static constexpr bool PERM = true, AFTER_DRAIN = false;
    const float* bias; const bf16_t* GCb; bf16_t* Y;
    __device__ __forceinline__ void operator()(const f32x4 (&acc)[2][2][4][2], const Unit& u, int wr, int wc, int fr, int fq) const {
        const int row0 = u.pm * BM + wr * 64 + fr, col0 = u.pn * BM + wc * 32 + 8 * fq;
        f32x4 bv[2][2];
#pragma unroll
        for (int bj = 0; bj < 2; ++bj)
#pragma unroll
            for (int n = 0; n < 2; ++n) bv[bj][n] = *(const f32x4*)(bias + col0 + bj * HALF + 4 * n);
#pragma unroll
        for (int ai = 0; ai < 2; ++ai)
#pragma unroll
            for (int m = 0; m < 4; ++m) { const size_t row = (size_t)(row0 + ai * HALF + m * 16);
#pragma unroll
                for (int bj = 0; bj < 2; ++bj) { const int c = col0 + bj * HALF; const u32x4 gc = *(const u32x4*)(GCb + row * 512 + c);
                    f32x4 v0 = acc[ai][bj][m][0] + bv[bj][0], v1 = acc[ai][bj][m][1] + bv[bj][1];
                    v0 = v0 * (f32x4){bflo(gc.x), bfhi(gc.x), bflo(gc.y), bfhi(gc.y)}; v1 = v1 * (f32x4){bflo(gc.z), bfhi(gc.z), bflo(gc.w), bfhi(gc.w)};
                    store8(Y + row * 1024 + 512 + c, v0, v1); } }
    }
};
template <class Epi, class Sched, bool ALIGN_EPI = false, bool SP2 = false>
__device__ __forceinline__ void gemm_phase(PG8_LAS unsigned char* lds, const Gemm g, const Sched& S, const Epi& E) {
    const int tid = threadIdx.x, wid = __builtin_amdgcn_readfirstlane(tid >> 6), lane = tid & 63, wr = wid >> 2, wc = wid & 3, fr = lane & 15, fq = lane >> 4;
    const int K = g.K, nt = K / BK;
    unsigned voffA[2], voffB[2];
#pragma unroll
    for (int i = 0; i < 2; ++i) { int R, C; stage_rc(tid * 16 + i * 8192, R, C); const int Rb = Epi::PERM ? ((R & ~31) + perm32(R & 31)) : R;
        voffA[i] = (unsigned)(R * K + C) * 2u; voffB[i] = (unsigned)(Rb * K + C) * 2u; }
    const size_t kstep = (size_t)(BK * 2);
    const size_t hstep = (size_t)HALF * K * 2;
    const size_t tstep = 2 * hstep;
    const unsigned ldsw = (unsigned)wid * 1024u;
    const int aoff = lds_byte(wr * 64 + fr, fq * 8), boff = lds_byte(wc * 32 + fr, fq * 8);
#define PG8_SA(b, h) (((b) * 2 + (h)) * HTB)
#define PG8_SB(b, h) ((4 + (b) * 2 + (h)) * HTB)
#define PG8_STAGE(bufoff, gbase, voff) do { _Pragma("unroll") for (int _i = 0; _i < 2; ++_i) \
        __builtin_amdgcn_global_load_lds((const unsigned*)((const char*)(gbase) + (voff)[_i]), (PG8_LAS unsigned*)(lds + (bufoff) + ldsw + _i * 8192), 16, 0, 0); } while (0)
#define PG8_LDA(dst, b, h) do { _Pragma("unroll") for (int m = 0; m < 4; ++m) _Pragma("unroll") for (int k = 0; k < 2; ++k) dst[m][k] = *(const PG8_LAS bf16x8*)(lds + PG8_SA(b, h) + aoff + m * 2048 + k * 1024); } while (0)
#define PG8_LDB(dst, b, h) do { _Pragma("unroll") for (int n = 0; n < 2; ++n) _Pragma("unroll") for (int k = 0; k < 2; ++k) dst[n][k] = *(const PG8_LAS bf16x8*)(lds + PG8_SB(b, h) + boff + n * 2048 + k * 1024); } while (0)
#define PG8_MMA(ai, bj, At, Bt) do { __builtin_amdgcn_s_setprio(1); _Pragma("unroll") for (int m = 0; m < 4; ++m) _Pragma("unroll") for (int n = 0; n < 2; ++n) _Pragma("unroll") for (int k = 0; k < 2; ++k) \
        acc[ai][bj][m][n] = __builtin_amdgcn_mfma_f32_16x16x32_bf16(Bt[n][k], At[m][k], acc[ai][bj][m][n], 0, 0, 0); __builtin_amdgcn_s_setprio(0); } while (0)
#define PG8_WAIT_V(n) asm volatile("s_waitcnt vmcnt(" #n ")" ::: "memory")
#define PG8_WAIT_L(n) asm volatile("s_waitcnt lgkmcnt(" #n ")" ::: "memory")
#define PG8_BAR __builtin_amdgcn_s_barrier()
#define PG8_SCHED __builtin_amdgcn_sched_barrier(0)
    Unit cur, nxt; int ui = 0;
    if (!S.next(0, cur)) return;
    f32x4 acc[2][2][4][2];
#pragma unroll
    for (int a = 0; a < 2; ++a)
#pragma unroll
        for (int b = 0; b < 2; ++b)
#pragma unroll
            for (int m = 0; m < 4; ++m)
#pragma unroll
                for (int n = 0; n < 2; ++n) acc[a][b][m][n] = (f32x4){0.f, 0.f, 0.f, 0.f};
    bf16x8 At[4][2], B0[2][2], B1[2][2];
    const char* cA = (const char*)g.A + (size_t)cur.pm * tstep; const char* cB = (const char*)g.Bt + (size_t)cur.pn * tstep;
    S.a_ready(cur);
    if constexpr (SP2) {
        PG8_STAGE(PG8_SB(0, 0), cB, voffB); PG8_STAGE(PG8_SB(0, 1), cB + hstep, voffB); PG8_STAGE(PG8_SA(0, 0), cA, voffA); PG8_STAGE(PG8_SA(0, 1), cA + hstep, voffA);
        if (wr == 1) PG8_BAR;
        PG8_WAIT_V(2); PG8_BAR;
        PG8_STAGE(PG8_SB(1, 0), cB + kstep, voffB); PG8_STAGE(PG8_SA(1, 0), cA + kstep, voffA); PG8_STAGE(PG8_SB(1, 1), cB + hstep + kstep, voffB);
        PG8_WAIT_V(6); PG8_BAR;
    } else {
        PG8_STAGE(PG8_SB(0, 0), cB, voffB); PG8_STAGE(PG8_SA(0, 0), cA, voffA); PG8_STAGE(PG8_SB(0, 1), cB + hstep, voffB); PG8_STAGE(PG8_SA(0, 1), cA + hstep, voffA);
        if (wr == 1) PG8_BAR;
        PG8_WAIT_V(4); PG8_BAR;
        PG8_STAGE(PG8_SB(1, 0), cB + kstep, voffB); PG8_STAGE(PG8_SA(1, 0), cA + kstep, voffA); PG8_STAGE(PG8_SB(1, 1), cB + hstep + kstep, voffB);
        PG8_WAIT_V(6); PG8_BAR;
    }
    for (;;) {
        const bool has_next = S.next(ui + 1, nxt);
        const char* nA = has_next ? (const char*)g.A + (size_t)nxt.pm * tstep : cA; const char* nB = has_next ? (const char*)g.Bt + (size_t)nxt.pn * tstep : cB;
        for (int t = 0; t < nt; t += 2) {
            const bool last = (t == nt - 2);
            const char* a1 = cA + (size_t)(t + 1) * kstep;
            const char* a2 = last ? nA : cA + (size_t)(t + 2) * kstep; const char* b2 = last ? nB : cB + (size_t)(t + 2) * kstep;
            const char* a3 = a2 + kstep; const char* b3 = b2 + kstep;
            if (last && has_next) S.a_ready(nxt);
            if constexpr (SP2) {
            PG8_LDB(B0, 0, 0); PG8_LDB(B1, 0, 1); PG8_SCHED; PG8_LDA(At, 0, 0); PG8_STAGE(PG8_SA(1, 1), a1 + hstep, voffA);
            PG8_WAIT_V(8); PG8_WAIT_L(0); PG8_BAR; PG8_MMA(0, 0, At, B0); PG8_MMA(0, 1, At, B1); PG8_BAR; PG8_SCHED;
            PG8_LDA(At, 0, 1); PG8_STAGE(PG8_SB(0, 0), b2, voffB); PG8_STAGE(PG8_SB(0, 1), b2 + hstep, voffB); PG8_STAGE(PG8_SA(0, 0), a2, voffA);
            PG8_WAIT_V(8); PG8_WAIT_L(0); PG8_BAR; PG8_MMA(1, 0, At, B0); PG8_MMA(1, 1, At, B1); PG8_BAR; PG8_SCHED;
            PG8_LDB(B0, 1, 0); PG8_LDB(B1, 1, 1); PG8_SCHED; PG8_LDA(At, 1, 0); PG8_STAGE(PG8_SA(0, 1), a2 + hstep, voffA);
            PG8_WAIT_V(8); PG8_WAIT_L(0); PG8_BAR; PG8_MMA(0, 0, At, B0); PG8_MMA(0, 1, At, B1); PG8_BAR; PG8_SCHED;
            PG8_LDA(At, 1, 1); PG8_STAGE(PG8_SB(1, 0), b3, voffB); PG8_STAGE(PG8_SB(1, 1), b3 + hstep, voffB); PG8_STAGE(PG8_SA(1, 0), a3, voffA);
            PG8_WAIT_V(8); PG8_WAIT_L(0); PG8_BAR; PG8_MMA(1, 0, At, B0); PG8_MMA(1, 1, At, B1); PG8_BAR; PG8_SCHED;
            } else {
            PG8_LDB(B0, 0, 0); PG8_SCHED; PG8_LDA(At, 0, 0); PG8_STAGE(PG8_SA(1, 1), a1 + hstep, voffA);
            PG8_WAIT_L(8); PG8_BAR; PG8_WAIT_L(0); PG8_MMA(0, 0, At, B0); PG8_BAR; PG8_SCHED;
            PG8_LDB(B1, 0, 1); PG8_STAGE(PG8_SB(0, 0), b2, voffB);
            PG8_BAR; PG8_WAIT_L(0); PG8_MMA(0, 1, At, B1); PG8_BAR;
            PG8_LDA(At, 0, 1); PG8_STAGE(PG8_SA(0, 0), a2, voffA);
            PG8_BAR; PG8_WAIT_L(0); PG8_MMA(1, 0, At, B0); PG8_BAR; PG8_SCHED;
            PG8_STAGE(PG8_SB(0, 1), b2 + hstep, voffB);
            PG8_WAIT_V(6); PG8_BAR; PG8_MMA(1, 1, At, B1); PG8_BAR;
            PG8_LDB(B0, 1, 0); PG8_SCHED; PG8_LDA(At, 1, 0); PG8_STAGE(PG8_SA(0, 1), a2 + hstep, voffA);
            PG8_WAIT_L(8); PG8_BAR; PG8_WAIT_L(0); PG8_MMA(0, 0, At, B0); PG8_BAR; PG8_SCHED;
            PG8_LDB(B1, 1, 1); PG8_STAGE(PG8_SB(1, 0), b3, voffB);
            PG8_BAR; PG8_WAIT_L(0); PG8_MMA(0, 1, At, B1); PG8_BAR;
            PG8_LDA(At, 1, 1); PG8_STAGE(PG8_SA(1, 0), a3, voffA);
            PG8_BAR; PG8_WAIT_L(0); PG8_MMA(1, 0, At, B0); PG8_BAR; PG8_SCHED;
            PG8_STAGE(PG8_SB(1, 1), b3 + hstep, voffB);
            PG8_WAIT_V(6); PG8_BAR; PG8_MMA(1, 1, At, B1); PG8_BAR;
            }
        }
        if constexpr (ALIGN_EPI) { if (wr == 0) PG8_BAR; }
        if constexpr (!Epi::AFTER_DRAIN) { E(acc, cur, wr, wc, fr, fq); S.done(cur); }
        if (!has_next) break;
#pragma unroll
        for (int a = 0; a < 2; ++a)
#pragma unroll
            for (int b = 0; b < 2; ++b)
#pragma unroll
                for (int m = 0; m < 4; ++m)
#pragma unroll
                    for (int n = 0; n < 2; ++n) acc[a][b][m][n] = (f32x4){0.f, 0.f, 0.f, 0.f};
        cur = nxt; cA = nA; cB = nB; ++ui;
        if constexpr (ALIGN_EPI) { if (wr == 1) PG8_BAR; }
    }
    PG8_WAIT_V(0);
    if constexpr (!ALIGN_EPI) { if (wr == 0) PG8_BAR; }
    PG8_BAR;
    if constexpr (Epi::AFTER_DRAIN) { E.fused(acc, cur, wr, wc, fr, fq, lds, wid, lane); S.done(cur); }
#undef PG8_SA
#undef PG8_SB
#undef PG8_STAGE
#undef PG8_LDA
#undef PG8_LDB
#undef PG8_MMA
#undef PG8_WAIT_V
#undef PG8_WAIT_L
#undef PG8_BAR
#undef PG8_SCHED
}
}

#ifndef PG8_SP2
#define PG8_SP2 true
#endif
#ifndef PG8_ALIGN
#define PG8_ALIGN true
#endif
#define GAS __attribute__((address_space(1)))
#define LAS __attribute__((address_space(3)))
typedef unsigned short bf16;
typedef unsigned v4u __attribute__((ext_vector_type(4)));
typedef unsigned v2u __attribute__((ext_vector_type(2)));
typedef float f32x4 __attribute__((ext_vector_type(4)));
typedef short bf16x8 __attribute__((ext_vector_type(8)));
typedef GAS unsigned gu32;
typedef GAS unsigned long long gu64;
#define RLX_AGENT __ATOMIC_RELAXED, __HIP_MEMORY_SCOPE_AGENT
#define LDS_WAIT() asm volatile("s_waitcnt lgkmcnt(0)" ::: "memory")
#define VM_WAIT() asm volatile("s_waitcnt vmcnt(0)" ::: "memory")
__device__ __forceinline__ unsigned f2bf(float f) { unsigned u = __builtin_bit_cast(unsigned, f); return (u + 0x7fffu + ((u >> 16) & 1u)) >> 16; }
__device__ __forceinline__ unsigned pk2(float lo, float hi) { return f2bf(lo) | (f2bf(hi) << 16); }
__device__ __forceinline__ float bf2f(bf16 b) { return __uint_as_float(((unsigned)b) << 16); }
__device__ __forceinline__ float wave_sum(float v) {
#pragma unroll
    for (int o = 1; o < 64; o <<= 1) v += __shfl_xor(v, o);
    return v;
}
__device__ __forceinline__ float wave_max(float v) {
#pragma unroll
    for (int o = 1; o < 64; o <<= 1) v = fmaxf(v, __shfl_xor(v, o));
    return v;
}
#define XB_TMO      128
#define XB_XCNT(j)  (256  + 64 * (j))
#define XB_XSUB(j)  (1280 + 64 * (j))
#define XB_XGEN(j)  (2304 + 64 * (j))
#define XB_TOP      3328
#define XB_TOPGEN   3392
#define XCD_BAR_WORDS 3456
#define XB_SPIN_CAP (1u << 18)

__device__ __forceinline__ unsigned xb_ld(unsigned* p)              { return __hip_atomic_load(p, __ATOMIC_RELAXED, __HIP_MEMORY_SCOPE_AGENT); }
__device__ __forceinline__ unsigned xb_add(unsigned* p, unsigned v) { return __hip_atomic_fetch_add(p, v, __ATOMIC_RELAXED, __HIP_MEMORY_SCOPE_AGENT); }
__device__ __forceinline__ unsigned xb_xcc_id() { return (unsigned)__builtin_amdgcn_s_getreg((3 << 11) | 20) & 0xFu; }
#define XB_SPIN(cond, bar) do { unsigned _sp = 0; while (cond) { __builtin_amdgcn_s_sleep(1); \
    if ((++_sp & 255u) == 0u) { if (xb_ld(&(bar)[XB_TMO])) break; if (_sp > XB_SPIN_CAP) { atomicAdd(&(bar)[XB_TMO], 1u); break; } } } } while (0)

struct XcdBarrier {
    unsigned* bar; unsigned x;
    volatile LAS unsigned* st;
};

__device__ __forceinline__ XcdBarrier xcd_barrier_post(unsigned* bar, volatile LAS unsigned* st) {
    XcdBarrier b; b.bar = bar; b.x = xb_xcc_id(); b.st = st;
    if (threadIdx.x == 0) (void)xb_add(&bar[XB_XCNT(b.x)], 1u);
    return b;
}
__device__ __forceinline__ void xcd_barrier_complete(unsigned* bar, unsigned x, unsigned& nloc, unsigned& nx) {
    const unsigned G = gridDim.x * gridDim.y * gridDim.z;
    unsigned sum, cnt, mine, sp = 0u;
    for (;;) {
        sum = 0u; cnt = 0u; mine = 0u;
#pragma unroll
        for (unsigned j = 0; j < 16; ++j) { const unsigned c = xb_ld(&bar[XB_XCNT(j)]); sum += c; cnt += (c > 0u) ? 1u : 0u; mine = (j == x) ? c : mine; }
        if (sum == G) break;
        __builtin_amdgcn_s_sleep(1);
        if ((++sp & 255u) == 0u) { if (xb_ld(&bar[XB_TMO])) break; if (sp > XB_SPIN_CAP) { atomicAdd(&bar[XB_TMO], 1u); break; } }
    }
    nloc = mine > 0u ? mine : 1u; nx = cnt > 0u ? cnt : 1u;
}

__device__ __forceinline__ void xcd_barrier(const XcdBarrier& b) {
    asm volatile("s_waitcnt vmcnt(0)" ::: "memory");
    __syncthreads();
    if (threadIdx.x == 0) {
        unsigned* bar = b.bar;
        __builtin_amdgcn_s_waitcnt(0);
        unsigned nloc = b.st[0], nx = b.st[1];
        if (nloc == 0u) { xcd_barrier_complete(bar, b.x, nloc, nx); b.st[0] = nloc; b.st[1] = nx; }
        const unsigned old = xb_add(&bar[XB_XSUB(b.x)], 1u);
        const unsigned gen = old / nloc;
        if (old + 1u == (gen + 1u) * nloc) {
            __builtin_amdgcn_fence(__ATOMIC_RELEASE, "agent");
            asm volatile("s_waitcnt vmcnt(0)" ::: "memory");
            const unsigned og = xb_add(&bar[XB_TOP], 1u);
            const unsigned tg = og / nx;
            if (og + 1u == (tg + 1u) * nx) xb_add(&bar[XB_TOPGEN], 1u);
            else XB_SPIN(xb_ld(&bar[XB_TOPGEN]) == tg, bar);
            __builtin_amdgcn_fence(__ATOMIC_ACQUIRE, "agent");
            xb_add(&bar[XB_XGEN(b.x)], 1u);
            asm volatile("s_waitcnt vmcnt(0)" ::: "memory");
        } else {
            XB_SPIN(xb_ld(&bar[XB_XGEN(b.x)]) == gen, bar);
            __builtin_amdgcn_fence(__ATOMIC_ACQUIRE, "agent");
            asm volatile("s_waitcnt vmcnt(0)" ::: "memory");
        }
    }
    __syncthreads();
}

constexpr int NWAVES = 8;
#ifndef MK_N_LAUNCHES
#define MK_N_LAUNCHES 1
#endif
constexpr int NPHASE = 7;
constexpr int N_LAUNCHES = MK_N_LAUNCHES;
static_assert(N_LAUNCHES == 1 || N_LAUNCHES == NPHASE, "MK_N_LAUNCHES is 1 or 7");
constexpr int BATCH = 8, SEQ = 2048, D = 1024, M = BATCH * SEQ;
constexpr int NIN = 3072, NIN_ORIG = 3012, DH = 512;
constexpr int CONVW = 31, TOPK = 256;
constexpr float EPS = 1e-6f;
constexpr float C2 = 0.125f * 1.4426950408889634f;

constexpr size_t MiB = 1u << 20;
constexpr size_t WS_CTL = 0, CTL_ZERO_BYTES = 1 * MiB;
constexpr size_t WS_MOD = 1 * MiB;
constexpr size_t WS_WIN = 2 * MiB;
constexpr size_t WS_WPW = 8 * MiB;
constexpr size_t WS_WOUT = 9 * MiB;
constexpr size_t WS_X = 11 * MiB;
constexpr size_t WS_HB = 16 * MiB;
constexpr size_t WS_QB = 48 * MiB;
constexpr size_t WS_GAB = 64 * MiB;
constexpr size_t WS_QIB = 80 * MiB;
constexpr size_t WS_KB = 88 * MiB, WS_VB = 90 * MiB, WS_KIB = 92 * MiB;
constexpr size_t WS_WI = 94 * MiB;
constexpr size_t WS_UB = 96 * MiB;
constexpr size_t WS_GCB = 112 * MiB;
constexpr size_t WS_A2B = 128 * MiB;
constexpr size_t WS_YCAT = 144 * MiB;
constexpr size_t WS_YF = 176 * MiB;
constexpr size_t WS_END = 240 * MiB;
constexpr int CW_TMO = 0, CW_CODE = 1, CW_BAR = 4096, CW_SEAM = 16384;

constexpr int RING_OFF = 0, RING_BYTES = 131072;
constexpr int LDSCTL_OFF = RING_BYTES, MISC_OFF = LDSCTL_OFF + 320;
constexpr int LDS_BYTES = 147456;

__host__ __device__ __forceinline__ int win_orig_col(int n) {
    const int pn = n >> 8, c = n & 255;
    if (pn < 2) return n;
    if (pn < 4) return 640 + (n - 512);
    if (pn == 4) return 1152 + c;
    if (pn == 5) { if (c < 64) return 512 + c; if (c < 128) return 576 + (c - 64); if (c < 192) return 1408 + (c - 128); if (c < 196) return 1472 + (c - 192); return -1; }
    if (pn < 10) { const int j = pn - 6; return c < 128 ? 1476 + 128 * j + c : 1988 + 128 * j + (c - 128); }
    return 2500 + (n - 2560);
}

struct Frame {
    LAS unsigned char* lds;
    volatile LAS unsigned* MISC;
    gu32* ctl;
    int tid, lane, wave, vcu, G;
    const float *x, *c, *w_ada, *b_ada, *g_pre, *w_in, *w_dw, *b_dw, *g_cn, *b_cn, *w_pw2, *b_pw2, *w_out, *g_post;
    float* out;
    float *MOD, *WI, *YF;
    bf16 *WIN, *WPW, *WOUT, *HB, *QB, *GAB, *QIB, *KB, *VB, *KIB, *UB, *GCB, *A2B, *YCAT;
};

template <bool MAPPED>
__device__ __forceinline__ void p0_transpose_item(const float* W, int K, int ldw, bf16* WT, LAS float* scr, int item, int nblk, int lane) {
    const int kb = item / nblk, nb = item % nblk, k0 = 64 * kb, n0 = 32 * nb;
    const int oc = MAPPED ? win_orig_col(n0 + (lane & 31)) : (n0 + (lane & 31));
#pragma unroll 8
    for (int i = 0; i < 32; ++i) { const int kk = 2 * i + (lane >> 5); scr[kk * 33 + (lane & 31)] = (oc >= 0) ? W[(size_t)(k0 + kk) * ldw + oc] : 0.f; }
    LDS_WAIT(); asm volatile("" ::: "memory");
    const int c = lane & 7;
#pragma unroll
    for (int j = 0; j < 4; ++j) { const int n = (lane >> 3) + 8 * j; const LAS float* s = scr + (8 * c) * 33 + n;
        v4u o; o.x = pk2(s[0 * 33], s[1 * 33]); o.y = pk2(s[2 * 33], s[3 * 33]); o.z = pk2(s[4 * 33], s[5 * 33]); o.w = pk2(s[6 * 33], s[7 * 33]);
        *(GAS v4u*)(WT + (size_t)(n0 + n) * K + k0 + 8 * c) = o; }
    LDS_WAIT(); asm volatile("" ::: "memory");
}
__device__ __forceinline__ float silu_d(float x) { return x / (1.0f + __expf(-x)); }

__device__ __forceinline__ void p0_prologue(Frame& F) {
    LAS float* scr = (LAS float*)(F.lds + RING_OFF + F.wave * 16384);
    const int gw = F.vcu * NWAVES + F.wave, NGW = F.G * NWAVES;
    constexpr int I_IN = (D / 64) * (NIN / 32), I_PW = (DH / 64) * (DH / 32), I_OUT = (D / 64) * (D / 32);
    constexpr int NITEMS = I_IN + I_PW + I_OUT;
    for (int it = gw; it < NITEMS; it += NGW) {
        int r = it;
        if (r < I_IN) { p0_transpose_item<true>(F.w_in, D, NIN_ORIG, F.WIN, scr, r, NIN / 32, F.lane); continue; } r -= I_IN;
        if (r < I_PW) { p0_transpose_item<false>(F.w_pw2, DH, DH, F.WPW, scr, r, DH / 32, F.lane); continue; } r -= I_PW;
        p0_transpose_item<false>(F.w_out, D, D, F.WOUT, scr, r, D / 32, F.lane);
    }
    __syncthreads();
    if (F.vcu < 192) {
        LAS float* sc = (LAS float*)(F.lds + RING_OFF);
        LAS float* part = (LAS float*)(F.lds + RING_OFF + 32768);
        for (int i = F.tid; i < BATCH * D; i += NWAVES * 64) sc[i] = silu_d(F.c[i]);
        __syncthreads();
        const int j0 = 16 * F.vcu, c4 = F.tid & 3, kr = F.tid >> 2;
        f32x4 acc[8];
#pragma unroll
        for (int b = 0; b < 8; ++b) acc[b] = (f32x4){0.f, 0.f, 0.f, 0.f};
#pragma unroll
        for (int r = 0; r < 8; ++r) { const int i = kr * 8 + r; const f32x4 w = *(const GAS f32x4*)(F.w_ada + (size_t)i * (3 * D) + j0 + 4 * c4);
#pragma unroll
            for (int b = 0; b < 8; ++b) acc[b] += w * sc[b * D + i]; }
#pragma unroll
        for (int b = 0; b < 8; ++b)
#pragma unroll
            for (int e = 0; e < 4; ++e) { float v = acc[b][e]; v += __shfl_xor(v, 4); v += __shfl_xor(v, 8); v += __shfl_xor(v, 16); v += __shfl_xor(v, 32); acc[b][e] = v; }
        if (F.lane < 4) {
#pragma unroll
            for (int b = 0; b < 8; ++b)
#pragma unroll
                for (int e = 0; e < 4; ++e) part[F.wave * 128 + b * 16 + 4 * F.lane + e] = acc[b][e];
        }
        __syncthreads();
        if (F.tid < 128) { const int b = F.tid >> 4, col = F.tid & 15; float s = F.b_ada[j0 + col];
#pragma unroll
            for (int w = 0; w < 8; ++w) s += part[w * 128 + b * 16 + col];
            F.MOD[b * (3 * D) + j0 + col] = s; }
        __syncthreads();
    }
}

__device__ __forceinline__ void p1_rows(Frame& F) {
    const int gw = F.vcu * NWAVES + F.wave, NGW = F.G * NWAVES;
    for (int m = gw; m < M; m += NGW) {
        const int b = m / SEQ;
        const GAS f32x4* xr = (const GAS f32x4*)(F.x + (size_t)m * D) + F.lane;
        f32x4 v[4]; float s = 0.f;
#pragma unroll
        for (int j = 0; j < 4; ++j) { v[j] = xr[64 * j]; s += (v[j].x * v[j].x + v[j].y * v[j].y) + (v[j].z * v[j].z + v[j].w * v[j].w); }
        const float rstd = 1.0f / sqrtf(wave_sum(s) * (1.f / D) + EPS);
        GAS unsigned long long* o8 = (GAS unsigned long long*)(F.HB + (size_t)m * D) + F.lane;
#pragma unroll
        for (int j = 0; j < 4; ++j) { const int col = 4 * (F.lane + 64 * j);
            const f32x4 g = *(const GAS f32x4*)(F.g_pre + col), sh = *(const GAS f32x4*)(F.MOD + b * (3 * D) + col), scl = *(const GAS f32x4*)(F.MOD + b * (3 * D) + D + col);
            const f32x4 h = v[j] * rstd * g * (scl + 1.0f) + sh;
            o8[64 * j] = (unsigned long long)pk2(h.x, h.y) | ((unsigned long long)pk2(h.z, h.w) << 32); }
    }
}

__device__ __forceinline__ unsigned fkey(float f) { f += 0.0f; const unsigned u = __float_as_uint(f); return (u & 0x80000000u) ? ~u : (u | 0x80000000u); }
__device__ __forceinline__ int wave_cnt(bool p) { return __popcll(__ballot(p)); }
__device__ __forceinline__ int lane_prefix(bool p, int lane) { const unsigned long long m = __ballot(p); return __popcll(m & ((1ull << lane) - 1ull)); }

__device__ __forceinline__ void attn_naive_unit(Frame& F, int row) {
    LAS float* qi = (LAS float*)(F.lds + RING_OFF);
    LAS float* qh = (LAS float*)(F.lds + RING_OFF + 1024);
    LAS int* selidx = (LAS int*)(F.lds + RING_OFF + 3072);
    LAS int* red = (LAS int*)(F.lds + RING_OFF + 4096);
    LAS float* pb = (LAS float*)(F.lds + RING_OFF + 8192);
    const int b = row / SEQ, t = row % SEQ, n = t + 1, tid = F.tid, lane = F.lane, wave = F.wave;
    if (tid < 256) qi[tid] = bf2f(F.QIB[(size_t)row * 256 + tid]);
    qh[tid] = bf2f(F.QB[(size_t)row * 512 + tid]);
    const f32x4 wv = *(const GAS f32x4*)(F.WI + (size_t)row * 4);
    __syncthreads();
    unsigned key[4]; bool sel[4]; int pos[4];
#pragma unroll
    for (int j = 0; j < 4; ++j) {
        const int s = wave * 256 + 64 * j + lane; key[j] = 0u;
        if (s <= t) {
            const GAS v4u* kr = (const GAS v4u*)(F.KIB + ((size_t)b * SEQ + s) * 64);
            float l0 = 0.f, l1 = 0.f, l2 = 0.f, l3 = 0.f;
#pragma unroll
            for (int c = 0; c < 8; ++c) { const v4u kv = kr[c]; const unsigned kw[4] = {kv.x, kv.y, kv.z, kv.w};
#pragma unroll
                for (int e = 0; e < 4; ++e) { const float k0 = __uint_as_float(kw[e] << 16), k1 = __uint_as_float(kw[e] & 0xffff0000u); const int d = 8 * c + 2 * e;
                    l0 += qi[d] * k0 + qi[d + 1] * k1; l1 += qi[64 + d] * k0 + qi[64 + d + 1] * k1; l2 += qi[128 + d] * k0 + qi[128 + d + 1] * k1; l3 += qi[192 + d] * k0 + qi[192 + d + 1] * k1; } }
            const float scv = wv.x * fmaxf(l0, 0.f) + wv.y * fmaxf(l1, 0.f) + wv.z * fmaxf(l2, 0.f) + wv.w * fmaxf(l3, 0.f);
            key[j] = fkey(scv);
        }
    }
    int nsel;
    if (n <= TOPK) {
        nsel = n;
#pragma unroll
        for (int j = 0; j < 4; ++j) { const int s = wave * 256 + 64 * j + lane; sel[j] = (s <= t); pos[j] = s; }
    } else {
        nsel = TOPK;
        unsigned T = 0u;
        for (int bit = 31; bit >= 0; --bit) {
            const unsigned cand = T | (1u << bit);
            int c = 0;
#pragma unroll
            for (int j = 0; j < 4; ++j) c += wave_cnt(key[j] >= cand);
            if (lane == 0) red[(bit & 1) * 8 + wave] = c;
            __syncthreads();
            int tot = 0;
#pragma unroll
            for (int w = 0; w < 8; ++w) tot += red[(bit & 1) * 8 + w];
            if (tot >= TOPK) T = cand;
        }
        int cg = 0, ce = 0;
#pragma unroll
        for (int j = 0; j < 4; ++j) { cg += wave_cnt(key[j] > T); ce += wave_cnt(key[j] == T); }
        if (lane == 0) { red[16 + wave] = cg; red[24 + wave] = ce; }
        __syncthreads();
        int totg = 0, base_eq = 0;
#pragma unroll
        for (int w = 0; w < 8; ++w) { totg += red[16 + w]; if (w < wave) base_eq += red[24 + w]; }
        const int r = TOPK - totg;
        int run = base_eq, cs = 0;
#pragma unroll
        for (int j = 0; j < 4; ++j) { const bool eq = (key[j] == T); const int my = run + lane_prefix(eq, lane); sel[j] = (key[j] > T) || (eq && my < r); run += wave_cnt(eq); cs += wave_cnt(sel[j]); }
        if (lane == 0) red[32 + wave] = cs;
        __syncthreads();
        int base = 0;
#pragma unroll
        for (int w = 0; w < 8; ++w) if (w < wave) base += red[32 + w];
        run = base;
#pragma unroll
        for (int j = 0; j < 4; ++j) { pos[j] = run + lane_prefix(sel[j], lane); run += wave_cnt(sel[j]); }
    }
#pragma unroll
    for (int j = 0; j < 4; ++j) if (sel[j]) selidx[pos[j]] = wave * 256 + 64 * j + lane;
    __syncthreads();
    const float slope2 = exp2f(-(float)(wave + 1)) * 1.4426950408889634f;
    float sv[4]; float mx = -INFINITY;
#pragma unroll
    for (int j = 0; j < 4; ++j) { const int i = lane + 64 * j; sv[j] = -INFINITY;
        if (i < nsel) { const int s = selidx[i]; const GAS v4u* kr = (const GAS v4u*)(F.KB + ((size_t)b * SEQ + s) * 64); float dot = 0.f;
#pragma unroll
            for (int c = 0; c < 8; ++c) { const v4u kv = kr[c]; const unsigned kw[4] = {kv.x, kv.y, kv.z, kv.w};
#pragma unroll
                for (int e = 0; e < 4; ++e) { const int d = wave * 64 + 8 * c + 2 * e; dot += qh[d] * __uint_as_float(kw[e] << 16) + qh[d + 1] * __uint_as_float(kw[e] & 0xffff0000u); } }
            sv[j] = dot - slope2 * (float)(t - s); }
        mx = fmaxf(mx, sv[j]); }
    mx = wave_max(mx);
    float l = 0.f;
#pragma unroll
    for (int j = 0; j < 4; ++j) { const int i = lane + 64 * j; const float p = (i < nsel) ? exp2f(sv[j] - mx) : 0.f; pb[wave * 256 + i] = p; l += p; }
    l = wave_sum(l);
    __syncthreads();
    float o = 0.f;
    for (int ii = 0; ii < nsel; ++ii) { const int s = selidx[ii]; o += pb[wave * 256 + ii] * bf2f(F.VB[((size_t)b * SEQ + s) * 64 + lane]); }
    o = o / l;
    const float ga = bf2f(F.GAB[(size_t)row * 512 + wave * 64 + lane]);
    F.YCAT[(size_t)row * 1024 + wave * 64 + lane] = (bf16)f2bf(o * ga);
    __syncthreads();
}

__device__ __forceinline__ void conv_naive_unit(Frame& F, int row) {
    LAS float* red = (LAS float*)(F.lds + RING_OFF);
    const int b = row / SEQ, t = row % SEQ, c = F.tid;
    float acc = F.b_dw[c];
    for (int j = 0; j < CONVW; ++j) { const int tt = t - (CONVW - 1) + j; if (tt >= 0) acc += F.w_dw[j * DH + c] * bf2f(F.UB[((size_t)b * SEQ + tt) * DH + c]); }
    const float s = wave_sum(acc);
    if (F.lane == 0) red[F.wave] = s;
    __syncthreads();
    float mean = 0.f;
#pragma unroll
    for (int w = 0; w < 8; ++w) mean += red[w];
    mean *= (1.f / DH);
    const float d = acc - mean; const float q = wave_sum(d * d);
    if (F.lane == 0) red[8 + F.wave] = q;
    __syncthreads();
    float var = 0.f;
#pragma unroll
    for (int w = 0; w < 8; ++w) var += red[8 + w];
    var *= (1.f / DH);
    float y = d * (1.0f / sqrtf(var + EPS)) * F.g_cn[c] + F.b_cn[c];
    y = silu_d(y);
    F.A2B[(size_t)row * DH + c] = (bf16)f2bf(y);
    __syncthreads();
}

__device__ __forceinline__ void p6_rows(Frame& F) {
    const int gw = F.vcu * NWAVES + F.wave, NGW = F.G * NWAVES;
    for (int m = gw; m < M; m += NGW) {
        const int b = m / SEQ;
        const GAS f32x4* yr = (const GAS f32x4*)(F.YF + (size_t)m * D) + F.lane;
        const GAS f32x4* xr = (const GAS f32x4*)(F.x + (size_t)m * D) + F.lane;
        GAS f32x4* orow = (GAS f32x4*)(F.out + (size_t)m * D) + F.lane;
        f32x4 v[4]; float s = 0.f;
#pragma unroll
        for (int j = 0; j < 4; ++j) { v[j] = yr[64 * j]; s += (v[j].x * v[j].x + v[j].y * v[j].y) + (v[j].z * v[j].z + v[j].w * v[j].w); }
        const float rstd = 1.0f / sqrtf(wave_sum(s) * (1.f / D) + EPS);
#pragma unroll
        for (int j = 0; j < 4; ++j) { const int col = 4 * (F.lane + 64 * j);
            const f32x4 g = *(const GAS f32x4*)(F.g_post + col), gt = *(const GAS f32x4*)(F.MOD + b * (3 * D) + 2 * D + col);
            orow[64 * j] = xr[64 * j] + gt * (v[j] * rstd * g); }
    }
}

struct Args { const float* in[14]; float* out; unsigned char* ws; int ph_lo, ph_hi, li, pad; };
__global__ void __launch_bounds__(NWAVES * 64, 2) fwd_kernel(Args args) {
    extern __shared__ __attribute__((aligned(16))) unsigned char lds[];
    Frame F;
    F.lds = (LAS unsigned char*)lds;
    F.MISC = (volatile LAS unsigned*)(F.lds + MISC_OFF);
    F.tid = threadIdx.x; F.lane = F.tid & 63; F.wave = __builtin_amdgcn_readfirstlane(F.tid >> 6);
    F.G = gridDim.x; { const int bx = blockIdx.x; F.vcu = (F.G % 8 == 0) ? (bx % 8) * (F.G / 8) + bx / 8 : bx; }
    unsigned char* ws = args.ws;
    F.ctl = (gu32*)(ws + WS_CTL);
    F.x = args.in[0]; F.c = args.in[1]; F.w_ada = args.in[2]; F.b_ada = args.in[3]; F.g_pre = args.in[4]; F.w_in = args.in[5]; F.w_dw = args.in[6]; F.b_dw = args.in[7];
    F.g_cn = args.in[8]; F.b_cn = args.in[9]; F.w_pw2 = args.in[10]; F.b_pw2 = args.in[11]; F.w_out = args.in[12]; F.g_post = args.in[13]; F.out = args.out;
    F.MOD = (float*)(ws + WS_MOD); F.WI = (float*)(ws + WS_WI); F.YF = (float*)(ws + WS_YF);
    F.WIN = (bf16*)(ws + WS_WIN); F.WPW = (bf16*)(ws + WS_WPW); F.WOUT = (bf16*)(ws + WS_WOUT); F.HB = (bf16*)(ws + WS_HB); F.QB = (bf16*)(ws + WS_QB); F.GAB = (bf16*)(ws + WS_GAB);
    F.QIB = (bf16*)(ws + WS_QIB); F.KB = (bf16*)(ws + WS_KB); F.VB = (bf16*)(ws + WS_VB); F.KIB = (bf16*)(ws + WS_KIB); F.UB = (bf16*)(ws + WS_UB); F.GCB = (bf16*)(ws + WS_GCB);
    F.A2B = (bf16*)(ws + WS_A2B); F.YCAT = (bf16*)(ws + WS_YCAT);
    for (int u = F.tid; u < (LDS_BYTES - LDSCTL_OFF) / 4; u += NWAVES * 64) ((LAS unsigned*)(F.lds + LDSCTL_OFF))[u] = 0u;
    __syncthreads();
    XcdBarrier bar; bar.bar = (unsigned*)(F.ctl + CW_BAR); bar.x = 0; bar.st = nullptr;
    if (N_LAUNCHES == 1) bar = xcd_barrier_post((unsigned*)(F.ctl + CW_BAR), F.MISC + 8);
#define GRID_BAR() do { if (N_LAUNCHES == 1) xcd_barrier(bar); } while (0)
    const int lo = args.ph_lo, hi = args.ph_hi;
#define IN(k) (lo <= (k) && (k) < hi)
#define BOTH(k) (IN(k) && IN((k) + 1))

    if (IN(0)) { p0_prologue(F); if (BOTH(0)) GRID_BAR(); }
    if (IN(1)) { p1_rows(F); if (BOTH(1)) GRID_BAR(); }
    if (IN(2)) {
        pg8::Gemm g{F.HB, F.WIN, M, NIN, D}; pg8::StaticOrder S; S.init(M, NIN, F.G, (int)blockIdx.x);
        pg8::EpiInProj E{{F.QB, F.KB, F.VB, F.GAB, F.QIB, F.KIB, F.UB, F.GCB, F.WI}, C2};
        pg8::gemm_phase<pg8::EpiInProj, pg8::StaticOrder, PG8_ALIGN, PG8_SP2>(F.lds + RING_OFF, g, S, E);
        if (BOTH(2)) GRID_BAR();
    }
    if (IN(3)) {
        for (int row = F.vcu; row < M; row += F.G) conv_naive_unit(F, row);
        for (int row = F.vcu; row < M; row += F.G) attn_naive_unit(F, row);
        if (BOTH(3)) GRID_BAR();
    }
    if (IN(4)) {
        pg8::Gemm g{F.A2B, F.WPW, M, DH, DH}; pg8::StaticOrder S; S.init(M, DH, F.G, (int)blockIdx.x);
        pg8::EpiPw2 E{F.b_pw2, F.GCB, F.YCAT};
        pg8::gemm_phase<pg8::EpiPw2, pg8::StaticOrder, PG8_ALIGN, PG8_SP2>(F.lds + RING_OFF, g, S, E);
        if (BOTH(4)) GRID_BAR();
    }
    if (IN(5)) {
        pg8::Gemm g{F.YCAT, F.WOUT, M, D, D}; pg8::StaticOrder S; S.init(M, D, F.G, (int)blockIdx.x);
        pg8::EpiF32 E{F.YF, D};
        pg8::gemm_phase<pg8::EpiF32, pg8::StaticOrder, PG8_ALIGN, PG8_SP2>(F.lds + RING_OFF, g, S, E);
        if (BOTH(5)) GRID_BAR();
    }
    if (IN(6)) { p6_rows(F); }
#undef IN
#undef BOTH
}

extern "C" void kernel_launch(void* const* d_in, const int* in_sizes, int n_in, void* d_out, int out_size, void* d_ws, size_t ws_size, hipStream_t stream) {
    static int grid = 0;
    if (grid == 0) {
        if (n_in != 14 || in_sizes[0] != M * D || out_size != M * D || ws_size < WS_END) { fprintf(stderr, "kernel_launch: unexpected shapes (n_in %d, in0 %d, out %d, ws %zu); nothing launched\n", n_in, n_in > 0 ? in_sizes[0] : -1, out_size, ws_size); grid = -1; return; }
        int dev = 0, cus = 0, per_cu = 0;
        if (hipGetDevice(&dev) != hipSuccess || hipDeviceGetAttribute(&cus, hipDeviceAttributeMultiprocessorCount, dev) != hipSuccess) { fprintf(stderr, "kernel_launch: device query failed\n"); grid = -1; return; }
        if (hipFuncSetAttribute((const void*)fwd_kernel, hipFuncAttributeMaxDynamicSharedMemorySize, LDS_BYTES) != hipSuccess) { fprintf(stderr, "kernel_launch: hipFuncSetAttribute failed\n"); grid = -1; return; }
        if (hipOccupancyMaxActiveBlocksPerMultiprocessor(&per_cu, (const void*)fwd_kernel, NWAVES * 64, LDS_BYTES) != hipSuccess || per_cu < 1)
            fprintf(stderr, "kernel_launch: note: occupancy query reports %d workgroups per CU\n", per_cu);
        (void)hipGetLastError();
        grid = cus;
    }
    if (grid < 0) return;
    if (hipMemsetAsync((char*)d_ws + WS_CTL, 0, CTL_ZERO_BYTES, stream) != hipSuccess) { fprintf(stderr, "kernel_launch: memset failed\n"); return; }
    Args a{};
    for (int i = 0; i < 14; ++i) a.in[i] = (const float*)d_in[i];
    a.out = (float*)d_out; a.ws = (unsigned char*)d_ws;
    for (int li = 0; li < N_LAUNCHES; ++li) {
        a.ph_lo = (N_LAUNCHES == 1) ? 0 : li; a.ph_hi = (N_LAUNCHES == 1) ? NPHASE : li + 1; a.li = li;
        hipLaunchKernelGGL(fwd_kernel, dim3(grid), dim3(NWAVES * 64), LDS_BYTES, stream, a);
        const hipError_t le = hipPeekAtLastError();
        if (le != hipSuccess) { fprintf(stderr, "kernel_launch: launch %d failed: %s\n", li, hipGetErrorName(le)); break; }
    }
}
```

```cpp
#include <hip/hip_runtime.h>
#include <cstdio>
#include <cstdint>
namespace pg8 {
#define PG8_LAS __attribute__((address_space(3)))
typedef unsigned short bf16_t;
typedef short bf16x8 __attribute__((ext_vector_type(8)));
typedef float f32x4 __attribute__((ext_vector_type(4)));
typedef unsigned u32x4 __attribute__((ext_vector_type(4)));
constexpr int BM = 256, BK = 64, HALF = 128, HTB = HALF * BK * 2  , STAGE_BYTES = 8 * HTB, NXCD = 8, WGM = 8;

__host__ __device__ __forceinline__ int lds_byte(int r, int c) { const int st = (r >> 4) * 2 + (c >> 5), rr = r & 15, cc = c & 31, ob = rr * 64 + cc * 2; return st * 1024 + (ob ^ (((ob >> 9) & 1) << 5)); }
__host__ __device__ __forceinline__ void stage_rc(int b, int& R, int& C) { const int st = b / 1024, sb = b % 1024, swz = sb ^ (((sb >> 9) & 1) << 5); R = (st >> 1) * 16 + swz / 64; C = (st & 1) * 32 + (swz % 64) / 2; }
__host__ __device__ __forceinline__ int perm32(int rho) { const int n = rho >> 4, i = rho & 15; return 8 * (i >> 2) + 4 * n + (i & 3); }

struct Unit { int pm, pn; };
struct Gemm { const bf16_t* A; const bf16_t* Bt; int M, N, K; };

struct StaticOrder {
    int nM, nN, nwg, G, c;
    __host__ __device__ void init(int M, int N, int G_, int c_) { nM = M / BM; nN = N / BM; nwg = nM * nN; G = G_; c = c_; }
    __host__ __device__ bool next(int i, Unit& u) const {
        const long L = (long)i * G + c; if (L >= nwg) return false;
        int wgid = (int)L; { const int q = nwg / NXCD, r = nwg % NXCD, xcd = wgid % NXCD, off = wgid / NXCD; wgid = (xcd < r ? xcd * (q + 1) : r * (q + 1) + (xcd - r) * q) + off; }
        const int nig = WGM * nN, gid = wgid / nig, fm = gid * WGM, gsz = (nM - fm) < WGM ? (nM - fm) : WGM;
        u.pm = fm + ((wgid % nig) % gsz); u.pn = (wgid % nig) / gsz; return true;
    }
    __device__ __forceinline__ void a_ready(const Unit&) const {}
    __device__ __forceinline__ void done(const Unit&) const {}
};

__device__ __forceinline__ unsigned cvt_pk_bf16(float lo, float hi) { unsigned r; asm volatile("v_cvt_pk_bf16_f32 %0, %1, %2" : "=v"(r) : "v"(lo), "v"(hi)); return r; }
typedef float f32x2 __attribute__((ext_vector_type(2)));

__device__ __forceinline__ float sigm_f(float x) { return __builtin_amdgcn_rcpf(1.0f + __builtin_amdgcn_exp2f(-1.4426950408889634f * x)); }
__device__ __forceinline__ float silu_f(float x) { return x * sigm_f(x); }
__device__ __forceinline__ f32x4 silu4(f32x4 v) { return (f32x4){silu_f(v[0]), silu_f(v[1]), silu_f(v[2]), silu_f(v[3])}; }
__device__ __forceinline__ void store8(bf16_t* p, f32x4 v0, f32x4 v1) { u32x4 w; w.x = cvt_pk_bf16(v0[0], v0[1]); w.y = cvt_pk_bf16(v0[2], v0[3]); w.z = cvt_pk_bf16(v1[0], v1[1]); w.w = cvt_pk_bf16(v1[2], v1[3]); *(u32x4*)p = w; }
__device__ __forceinline__ float bflo(unsigned w) { return __uint_as_float(w << 16); }
__device__ __forceinline__ float bfhi(unsigned w) { return __uint_as_float(w & 0xffff0000u); }

struct EpiF32 {
    static constexpr bool PERM = false, AFTER_DRAIN = false;
    float* C; int ldc;
    __device__ __forceinline__ void operator()(const f32x4 (&acc)[2][2][4][2], const Unit& u, int wr, int wc, int fr, int fq) const {
        const int row0 = u.pm * BM + wr * 64 + fr, col0 = u.pn * BM + wc * 32 + 4 * fq;
#pragma unroll
        for (int ai = 0; ai < 2; ++ai)
#pragma unroll
            for (int m = 0; m < 4; ++m) { float* rowp = C + (size_t)(row0 + ai * HALF + m * 16) * ldc + col0;
#pragma unroll
                for (int bj = 0; bj < 2; ++bj)
#pragma unroll
                    for (int n = 0; n < 2; ++n) *(f32x4*)(rowp + bj * HALF + n * 16) = acc[ai][bj][m][n]; }
    }
};

struct InProjOut { bf16_t *Qb, *Kb, *Vb, *GAb, *QIb, *KIb, *Ub, *GCb; float* WI; };
struct EpiInProj {
    static constexpr bool PERM = true, AFTER_DRAIN = false;
    InProjOut o; float qscale;
    __device__ __forceinline__ void operator()(const f32x4 (&acc)[2][2][4][2], const Unit& u, int wr, int wc, int fr, int fq) const {
        const int row0 = u.pm * BM + wr * 64 + fr, cb = wc * 32 + 8 * fq, pn = u.pn;
#pragma unroll
        for (int ai = 0; ai < 2; ++ai)
#pragma unroll
            for (int m = 0; m < 4; ++m) {
                const size_t row = (size_t)(row0 + ai * HALF + m * 16);
                if (pn < 2) {
#pragma unroll
                    for (int bj = 0; bj < 2; ++bj) store8(o.Qb + row * 512 + pn * 256 + bj * HALF + cb, acc[ai][bj][m][0] * qscale, acc[ai][bj][m][1] * qscale);
                } else if (pn < 4) {
#pragma unroll
                    for (int bj = 0; bj < 2; ++bj) store8(o.GAb + row * 512 + (pn - 2) * 256 + bj * HALF + cb, silu4(acc[ai][bj][m][0]), silu4(acc[ai][bj][m][1]));
                } else if (pn == 4) {
#pragma unroll
                    for (int bj = 0; bj < 2; ++bj) store8(o.QIb + row * 256 + bj * HALF + cb, acc[ai][bj][m][0], acc[ai][bj][m][1]);
                } else if (pn == 5) {
                    if (wc < 2) { store8(o.Kb + row * 64 + cb, acc[ai][0][m][0], acc[ai][0][m][1]); store8(o.KIb + row * 64 + cb, acc[ai][1][m][0], acc[ai][1][m][1]); }
                    else { store8(o.Vb + row * 64 + (cb - 64), acc[ai][0][m][0], acc[ai][0][m][1]); if (wc == 2 && fq == 0) *(f32x4*)(o.WI + row * 4) = acc[ai][1][m][0]; }
                } else if (pn < 10) {
                    const f32x4 a0 = acc[ai][0][m][0], a1 = acc[ai][0][m][1], g0 = acc[ai][1][m][0], g1 = acc[ai][1][m][1];
                    const f32x4 u0 = (f32x4){a0[0] * sigm_f(g0[0]), a0[1] * sigm_f(g0[1]), a0[2] * sigm_f(g0[2]), a0[3] * sigm_f(g0[3])};
                    const f32x4 u1 = (f32x4){a1[0] * sigm_f(g1[0]), a1[1] * sigm_f(g1[1]), a1[2] * sigm_f(g1[2]), a1[3] * sigm_f(g1[3])};
                    store8(o.Ub + row * 512 + (pn - 6) * 128 + cb, u0, u1);
                } else {
#pragma unroll
                    for (int bj = 0; bj < 2; ++bj) store8(o.GCb + row * 512 + (pn - 10) * 256 + bj * HALF + cb, silu4(acc[ai][bj][m][0]), silu4(acc[ai][bj][m][1]));
                }
            }
    }
};

struct EpiPw2 {
    static constexpr bool PERM = true, AFTER_DRAIN = false;
    const float* bias; const bf16_t* GCb; bf16_t* Y;
    __device__ __forceinline__ void operator()(const f32x4 (&acc)[2][2][4][2], const Unit& u, int wr, int wc, int fr, int fq) const {
        const int row0 = u.pm * BM + wr * 64 + fr, col0 = u.pn * BM + wc * 32 + 8 * fq;
        f32x4 bv[2][2];
#pragma unroll
        for (int bj = 0; bj < 2; ++bj)
#pragma unroll
            for (int n = 0; n < 2; ++n) bv[bj][n] = *(const f32x4*)(bias + col0 + bj * HALF + 4 * n);
#pragma unroll
        for (int ai = 0; ai < 2; ++ai)
#pragma unroll
            for (int m = 0; m < 4; ++m) { const size_t row = (size_t)(row0 + ai * HALF + m * 16);
#pragma unroll
                for (int bj = 0; bj < 2; ++bj) { const int c = col0 + bj * HALF; const u32x4 gc = *(const u32x4*)(GCb + row * 512 + c);
                    f32x4 v0 = acc[ai][bj][m][0] + bv[bj][0], v1 = acc[ai][bj][m][1] + bv[bj][1];
                    v0 = v0 * (f32x4){bflo(gc.x), bfhi(gc.x), bflo(gc.y), bfhi(gc.y)}; v1 = v1 * (f32x4){bflo(gc.z), bfhi(gc.z), bflo(gc.w), bfhi(gc.w)};
                    store8(Y + row * 1024 + 512 + c, v0, v1); } }
    }
};
template <class Epi, class Sched, bool ALIGN_EPI = false, bool SP2 = false>
__device__ __forceinline__ void gemm_phase(PG8_LAS unsigned char* lds, const Gemm g, const Sched& S, const Epi& E) {
    const int tid = threadIdx.x, wid = __builtin_amdgcn_readfirstlane(tid >> 6), lane = tid & 63, wr = wid >> 2, wc = wid & 3, fr = lane & 15, fq = lane >> 4;
    const int K = g.K, nt = K / BK;
    unsigned voffA[2], voffB[2];
#pragma unroll
    for (int i = 0; i < 2; ++i) { int R, C; stage_rc(tid * 16 + i * 8192, R, C); const int Rb = Epi::PERM ? ((R & ~31) + perm32(R & 31)) : R;
        voffA[i] = (unsigned)(R * K + C) * 2u; voffB[i] = (unsigned)(Rb * K + C) * 2u; }
    const size_t kstep = (size_t)(BK * 2);
    const size_t hstep = (size_t)HALF * K * 2;
    const size_t tstep = 2 * hstep;
    const unsigned ldsw = (unsigned)wid * 1024u;
    const int aoff = lds_byte(wr * 64 + fr, fq * 8), boff = lds_byte(wc * 32 + fr, fq * 8);
#define PG8_SA(b, h) (((b) * 2 + (h)) * HTB)
#define PG8_SB(b, h) ((4 + (b) * 2 + (h)) * HTB)
#define PG8_STAGE(bufoff, gbase, voff) do { _Pragma("unroll") for (int _i = 0; _i < 2; ++_i) \
        __builtin_amdgcn_global_load_lds((const unsigned*)((const char*)(gbase) + (voff)[_i]), (PG8_LAS unsigned*)(lds + (bufoff) + ldsw + _i * 8192), 16, 0, 0); } while (0)
#define PG8_LDA(dst, b, h) do { _Pragma("unroll") for (int m = 0; m < 4; ++m) _Pragma("unroll") for (int k = 0; k < 2; ++k) dst[m][k] = *(const PG8_LAS bf16x8*)(lds + PG8_SA(b, h) + aoff + m * 2048 + k * 1024); } while (0)
#define PG8_LDB(dst, b, h) do { _Pragma("unroll") for (int n = 0; n < 2; ++n) _Pragma("unroll") for (int k = 0; k < 2; ++k) dst[n][k] = *(const PG8_LAS bf16x8*)(lds + PG8_SB(b, h) + boff + n * 2048 + k * 1024); } while (0)
#define PG8_MMA(ai, bj, At, Bt) do { __builtin_amdgcn_s_setprio(1); _Pragma("unroll") for (int m = 0; m < 4; ++m) _Pragma("unroll") for (int n = 0; n < 2; ++n) _Pragma("unroll") for (int k = 0; k < 2; ++k) \
        acc[ai][bj][m][n] = __builtin_amdgcn_mfma_f32_16x16x32_bf16(Bt[n][k], At[m][k], acc[ai][bj][m][n], 0, 0, 0); __builtin_amdgcn_s_setprio(0); } while (0)
#define PG8_WAIT_V(n) asm volatile("s_waitcnt vmcnt(" #n ")" ::: "memory")
#define PG8_WAIT_L(n) asm volatile("s_waitcnt lgkmcnt(" #n ")" ::: "memory")
#define PG8_BAR __builtin_amdgcn_s_barrier()
#define PG8_SCHED __builtin_amdgcn_sched_barrier(0)
    Unit cur, nxt; int ui = 0;
    if (!S.next(0, cur)) return;
    f32x4 acc[2][2][4][2];
#pragma unroll
    for (int a = 0; a < 2; ++a)
#pragma unroll
        for (int b = 0; b < 2; ++b)
#pragma unroll
            for (int m = 0; m < 4; ++m)
#pragma unroll
                for (int n = 0; n < 2; ++n) acc[a][b][m][n] = (f32x4){0.f, 0.f, 0.f, 0.f};
    bf16x8 At[4][2], B0[2][2], B1[2][2];
    const char* cA = (const char*)g.A + (size_t)cur.pm * tstep; const char* cB = (const char*)g.Bt + (size_t)cur.pn * tstep;
    S.a_ready(cur);
    if constexpr (SP2) {
        PG8_STAGE(PG8_SB(0, 0), cB, voffB); PG8_STAGE(PG8_SB(0, 1), cB + hstep, voffB); PG8_STAGE(PG8_SA(0, 0), cA, voffA); PG8_STAGE(PG8_SA(0, 1), cA + hstep, voffA);
        if (wr == 1) PG8_BAR;
        PG8_WAIT_V(2); PG8_BAR;
        PG8_STAGE(PG8_SB(1, 0), cB + kstep, voffB); PG8_STAGE(PG8_SA(1, 0), cA + kstep, voffA); PG8_STAGE(PG8_SB(1, 1), cB + hstep + kstep, voffB);
        PG8_WAIT_V(6); PG8_BAR;
    } else {
        PG8_STAGE(PG8_SB(0, 0), cB, voffB); PG8_STAGE(PG8_SA(0, 0), cA, voffA); PG8_STAGE(PG8_SB(0, 1), cB + hstep, voffB); PG8_STAGE(PG8_SA(0, 1), cA + hstep, voffA);
        if (wr == 1) PG8_BAR;
        PG8_WAIT_V(4); PG8_BAR;
        PG8_STAGE(PG8_SB(1, 0), cB + kstep, voffB); PG8_STAGE(PG8_SA(1, 0), cA + kstep, voffA); PG8_STAGE(PG8_SB(1, 1), cB + hstep + kstep, voffB);
        PG8_WAIT_V(6); PG8_BAR;
    }
    for (;;) {
        const bool has_next = S.next(ui + 1, nxt);
        const char* nA = has_next ? (const char*)g.A + (size_t)nxt.pm * tstep : cA; const char* nB = has_next ? (const char*)g.Bt + (size_t)nxt.pn * tstep : cB;
        for (int t = 0; t < nt; t += 2) {
            const bool last = (t == nt - 2);
            const char* a1 = cA + (size_t)(t + 1) * kstep;
            const char* a2 = last ? nA : cA + (size_t)(t + 2) * kstep; const char* b2 = last ? nB : cB + (size_t)(t + 2) * kstep;
            const char* a3 = a2 + kstep; const char* b3 = b2 + kstep;
            if (last && has_next) S.a_ready(nxt);
            if constexpr (SP2) {
            PG8_LDB(B0, 0, 0); PG8_LDB(B1, 0, 1); PG8_SCHED; PG8_LDA(At, 0, 0); PG8_STAGE(PG8_SA(1, 1), a1 + hstep, voffA);
            PG8_WAIT_V(8); PG8_WAIT_L(0); PG8_BAR; PG8_MMA(0, 0, At, B0); PG8_MMA(0, 1, At, B1); PG8_BAR; PG8_SCHED;
            PG8_LDA(At, 0, 1); PG8_STAGE(PG8_SB(0, 0), b2, voffB); PG8_STAGE(PG8_SB(0, 1), b2 + hstep, voffB); PG8_STAGE(PG8_SA(0, 0), a2, voffA);
            PG8_WAIT_V(8); PG8_WAIT_L(0); PG8_BAR; PG8_MMA(1, 0, At, B0); PG8_MMA(1, 1, At, B1); PG8_BAR; PG8_SCHED;
            PG8_LDB(B0, 1, 0); PG8_LDB(B1, 1, 1); PG8_SCHED; PG8_LDA(At, 1, 0); PG8_STAGE(PG8_SA(0, 1), a2 + hstep, voffA);
            PG8_WAIT_V(8); PG8_WAIT_L(0); PG8_BAR; PG8_MMA(0, 0, At, B0); PG8_MMA(0, 1, At, B1); PG8_BAR; PG8_SCHED;
            PG8_LDA(At, 1, 1); PG8_STAGE(PG8_SB(1, 0), b3, voffB); PG8_STAGE(PG8_SB(1, 1), b3 + hstep, voffB); PG8_STAGE(PG8_SA(1, 0), a3, voffA);
            PG8_WAIT_V(8); PG8_WAIT_L(0); PG8_BAR; PG8_MMA(1, 0, At, B0); PG8_MMA(1, 1, At, B1); PG8_BAR; PG8_SCHED;
            } else {
            PG8_LDB(B0, 0, 0); PG8_SCHED; PG8_LDA(At, 0, 0); PG8_STAGE(PG8_SA(1, 1), a1 + hstep, voffA);
            PG8_WAIT_L(8); PG8_BAR; PG8_WAIT_L(0); PG8_MMA(0, 0, At, B0); PG8_BAR; PG8_SCHED;
            PG8_LDB(B1, 0, 1); PG8_STAGE(PG8_SB(0, 0), b2, voffB);
            PG8_BAR; PG8_WAIT_L(0); PG8_MMA(0, 1, At, B1); PG8_BAR;
            PG8_LDA(At, 0, 1); PG8_STAGE(PG8_SA(0, 0), a2, voffA);
            PG8_BAR; PG8_WAIT_L(0); PG8_MMA(1, 0, At, B0); PG8_BAR; PG8_SCHED;
            PG8_STAGE(PG8_SB(0, 1), b2 + hstep, voffB);
            PG8_WAIT_V(6); PG8_BAR; PG8_MMA(1, 1, At, B1); PG8_BAR;
            PG8_LDB(B0, 1, 0); PG8_SCHED; PG8_LDA(At, 1, 0); PG8_STAGE(PG8_SA(0, 1), a2 + hstep, voffA);
            PG8_WAIT_L(8); PG8_BAR; PG8_WAIT_L(0); PG8_MMA(0, 0, At, B0); PG8_BAR; PG8_SCHED;
            PG8_LDB(B1, 1, 1); PG8_STAGE(PG8_SB(1, 0), b3, voffB);
            PG8_BAR; PG8_WAIT_L(0); PG8_MMA(0, 1, At, B1); PG8_BAR;
            PG8_LDA(At, 1, 1); PG8_STAGE(PG8_SA(1, 0), a3, voffA);
            PG8_BAR; PG8_WAIT_L(0); PG8_MMA(1, 0, At, B0); PG8_BAR; PG8_SCHED;
            PG8_STAGE(PG8_SB(1, 1), b3 + hstep, voffB);
            PG8_WAIT_V(6); PG8_BAR; PG8_MMA(1, 1, At, B1); PG8_BAR;
            }
        }
        if constexpr (ALIGN_EPI) { if (wr == 0) PG8_BAR; }
        if constexpr (!Epi::AFTER_DRAIN) { E(acc, cur, wr, wc, fr, fq); S.done(cur); }
        if (!has_next) break;
#pragma unroll
        for (int a = 0; a < 2; ++a)
#pragma unroll
            for (int b = 0; b < 2; ++b)
#pragma unroll
                for (int m = 0; m < 4; ++m)
#pragma unroll
                    for (int n = 0; n < 2; ++n) acc[a][b][m][n] = (f32x4){0.f, 0.f, 0.f, 0.f};
        cur = nxt; cA = nA; cB = nB; ++ui;
        if constexpr (ALIGN_EPI) { if (wr == 1) PG8_BAR; }
    }
    PG8_WAIT_V(0);
    if constexpr (!ALIGN_EPI) { if (wr == 0) PG8_BAR; }
    PG8_BAR;
    if constexpr (Epi::AFTER_DRAIN) { E.fused(acc, cur, wr, wc, fr, fq, lds, wid, lane); S.done(cur); }
#undef PG8_SA
#undef PG8_SB
#undef PG8_STAGE
#undef PG8_LDA
#undef PG8_LDB
#undef PG8_MMA
#undef PG8_WAIT_V
#undef PG8_WAIT_L
#undef PG8_BAR
#undef PG8_SCHED
}
}

#ifndef PG8_SP2
#define PG8_SP2 true
#endif
#ifndef PG8_ALIGN
#define PG8_ALIGN true
#endif
#define GAS __attribute__((address_space(1)))
#define LAS __attribute__((address_space(3)))
typedef unsigned short bf16;
typedef unsigned v4u __attribute__((ext_vector_type(4)));
typedef unsigned v2u __attribute__((ext_vector_type(2)));
typedef float f32x4 __attribute__((ext_vector_type(4)));
typedef short bf16x8 __attribute__((ext_vector_type(8)));
typedef GAS unsigned gu32;
typedef GAS unsigned long long gu64;
#define RLX_AGENT __ATOMIC_RELAXED, __HIP_MEMORY_SCOPE_AGENT
#define LDS_WAIT() asm volatile("s_waitcnt lgkmcnt(0)" ::: "memory")
#define VM_WAIT() asm volatile("s_waitcnt vmcnt(0)" ::: "memory")
__device__ __forceinline__ unsigned f2bf(float f) { unsigned u = __builtin_bit_cast(unsigned, f); return (u + 0x7fffu + ((u >> 16) & 1u)) >> 16; }
__device__ __forceinline__ unsigned pk2(float lo, float hi) { return f2bf(lo) | (f2bf(hi) << 16); }
__device__ __forceinline__ float bf2f(bf16 b) { return __uint_as_float(((unsigned)b) << 16); }
__device__ __forceinline__ float wave_sum(float v) {
#pragma unroll
    for (int o = 1; o < 64; o <<= 1) v += __shfl_xor(v, o);
    return v;
}
__device__ __forceinline__ float wave_max(float v) {
#pragma unroll
    for (int o = 1; o < 64; o <<= 1) v = fmaxf(v, __shfl_xor(v, o));
    return v;
}
#define XB_TMO      128
#define XB_XCNT(j)  (256  + 64 * (j))
#define XB_XSUB(j)  (1280 + 64 * (j))
#define XB_XGEN(j)  (2304 + 64 * (j))
#define XB_TOP      3328
#define XB_TOPGEN   3392
#define XCD_BAR_WORDS 3456
#define XB_SPIN_CAP (1u << 18)

__device__ __forceinline__ unsigned xb_ld(unsigned* p)              { return __hip_atomic_load(p, __ATOMIC_RELAXED, __HIP_MEMORY_SCOPE_AGENT); }
__device__ __forceinline__ unsigned xb_add(unsigned* p, unsigned v) { return __hip_atomic_fetch_add(p, v, __ATOMIC_RELAXED, __HIP_MEMORY_SCOPE_AGENT); }
__device__ __forceinline__ unsigned xb_xcc_id() { return (unsigned)__builtin_amdgcn_s_getreg((3 << 11) | 20) & 0xFu; }
#define XB_SPIN(cond, bar) do { unsigned _sp = 0; while (cond) { __builtin_amdgcn_s_sleep(1); \
    if ((++_sp & 255u) == 0u) { if (xb_ld(&(bar)[XB_TMO])) break; if (_sp > XB_SPIN_CAP) { atomicAdd(&(bar)[XB_TMO], 1u); break; } } } } while (0)

struct XcdBarrier {
    unsigned* bar; unsigned x;
    volatile LAS unsigned* st;
};

__device__ __forceinline__ XcdBarrier xcd_barrier_post(unsigned* bar, volatile LAS unsigned* st) {
    XcdBarrier b; b.bar = bar; b.x = xb_xcc_id(); b.st = st;
    if (threadIdx.x == 0) (void)xb_add(&bar[XB_XCNT(b.x)], 1u);
    return b;
}
__device__ __forceinline__ void xcd_barrier_complete(unsigned* bar, unsigned x, unsigned& nloc, unsigned& nx) {
    const unsigned G = gridDim.x * gridDim.y * gridDim.z;
    unsigned sum, cnt, mine, sp = 0u;
    for (;;) {
        sum = 0u; cnt = 0u; mine = 0u;
#pragma unroll
        for (unsigned j = 0; j < 16; ++j) { const unsigned c = xb_ld(&bar[XB_XCNT(j)]); sum += c; cnt += (c > 0u) ? 1u : 0u; mine = (j == x) ? c : mine; }
        if (sum == G) break;
        __builtin_amdgcn_s_sleep(1);
        if ((++sp & 255u) == 0u) { if (xb_ld(&bar[XB_TMO])) break; if (sp > XB_SPIN_CAP) { atomicAdd(&bar[XB_TMO], 1u); break; } }
    }
    nloc = mine > 0u ? mine : 1u; nx = cnt > 0u ? cnt : 1u;
}

__device__ __forceinline__ void xcd_barrier(const XcdBarrier& b) {
    asm volatile("s_waitcnt vmcnt(0)" ::: "memory");
    __syncthreads();
    if (threadIdx.x == 0) {
        unsigned* bar = b.bar;
        __builtin_amdgcn_s_waitcnt(0);
        unsigned nloc = b.st[0], nx = b.st[1];
        if (nloc == 0u) { xcd_barrier_complete(bar, b.x, nloc, nx); b.st[0] = nloc; b.st[1] = nx; }
        const unsigned old = xb_add(&bar[XB_XSUB(b.x)], 1u);
        const unsigned gen = old / nloc;
        if (old + 1u == (gen + 1u) * nloc) {
            __builtin_amdgcn_fence(__ATOMIC_RELEASE, "agent");
            asm volatile("s_waitcnt vmcnt(0)" ::: "memory");
            const unsigned og = xb_add(&bar[XB_TOP], 1u);
            const unsigned tg = og / nx;
            if (og + 1u == (tg + 1u) * nx) xb_add(&bar[XB_TOPGEN], 1u);
            else XB_SPIN(xb_ld(&bar[XB_TOPGEN]) == tg, bar);
            __builtin_amdgcn_fence(__ATOMIC_ACQUIRE, "agent");
            xb_add(&bar[XB_XGEN(b.x)], 1u);
            asm volatile("s_waitcnt vmcnt(0)" ::: "memory");
        } else {
            XB_SPIN(xb_ld(&bar[XB_XGEN(b.x)]) == gen, bar);
            __builtin_amdgcn_fence(__ATOMIC_ACQUIRE, "agent");
            asm volatile("s_waitcnt vmcnt(0)" ::: "memory");
        }
    }
    __syncthreads();
}

namespace att {
using bf16x8 = __attribute__((ext_vector_type(8))) short;
using s16x4 = __attribute__((ext_vector_type(4))) short;
using f32x16 = __attribute__((ext_vector_type(16))) float;
using u32x4 = __attribute__((ext_vector_type(4))) unsigned;
typedef unsigned short bf16;
constexpr int SEQ = 2048, NW = 8, QBLK = 32, KVBLK = 64, TOPK = 256;
constexpr int NSLOT = 3, SLOTB = 8192;
constexpr int LDS_K = 0, LDS_V = NSLOT * SLOTB, LDS_WS = 2 * NSLOT * SLOTB, LDS_OST = LDS_WS + NW * 64 * 4, LDS_MASK = LDS_OST + NW * 4096;
constexpr int LDS_QI = LDS_MASK + 8192;
constexpr int LDS_EX = LDS_QI + 16384;
constexpr int LDS_END = LDS_EX + 4096;
__device__ __forceinline__ int crow(int r, int hi) { return (r & 3) + 8 * (r >> 2) + 4 * hi; }
#define SBAR() __builtin_amdgcn_sched_barrier(0)
__device__ __forceinline__ void glds16(const void* gsrc, unsigned lds_dst) { unsigned keep;
  asm volatile("s_mov_b32 %0, m0\n\ts_mov_b32 m0, %2\n\ts_nop 0\n\tglobal_load_lds_dwordx4 %1, off\n\ts_mov_b32 m0, %0" : "=&s"(keep) : "v"(gsrc), "s"(lds_dst) : "memory"); }
__device__ __forceinline__ float fadd_s(float a, float b) { float r; asm("v_add_f32_e32 %0, %1, %2" : "=v"(r) : "v"(a), "v"(b)); return r; }
__device__ __forceinline__ float fsub_s(float a, float b) { float r; asm("v_sub_f32_e32 %0, %1, %2" : "=v"(r) : "v"(a), "v"(b)); return r; }
typedef float f32x2_t __attribute__((ext_vector_type(2))); typedef __bf16 bf16x2_t __attribute__((ext_vector_type(2)));
__device__ __forceinline__ unsigned cvtpk_s(float lo, float hi) { f32x2_t v = {lo, hi}; bf16x2_t b = __builtin_convertvector(v, bf16x2_t); return __builtin_bit_cast(unsigned, b); }
#define WAIT_BAR(N) asm volatile("s_waitcnt vmcnt(" #N ") lgkmcnt(0)\n\ts_barrier" ::: "memory")
typedef __attribute__((address_space(3))) const char* lds_cptr;
typedef short v4i16_t __attribute__((ext_vector_type(4)));
__device__ __forceinline__ void kload8(bf16x8* kf, lds_cptr kp) {
  kf[0] = *(const __attribute__((address_space(3))) bf16x8*)(kp);        kf[1] = *(const __attribute__((address_space(3))) bf16x8*)(kp + 512);
  kf[2] = *(const __attribute__((address_space(3))) bf16x8*)(kp + 2048); kf[3] = *(const __attribute__((address_space(3))) bf16x8*)(kp + 2560);
  kf[4] = *(const __attribute__((address_space(3))) bf16x8*)(kp + 4096); kf[5] = *(const __attribute__((address_space(3))) bf16x8*)(kp + 4608);
  kf[6] = *(const __attribute__((address_space(3))) bf16x8*)(kp + 6144); kf[7] = *(const __attribute__((address_space(3))) bf16x8*)(kp + 6656);
}
__device__ __forceinline__ void kload2(bf16x8* kf, lds_cptr kp, int j) { kf[2 * j] = *(const __attribute__((address_space(3))) bf16x8*)(kp + j * 2048); kf[2 * j + 1] = *(const __attribute__((address_space(3))) bf16x8*)(kp + j * 2048 + 512); }
__device__ __forceinline__ s16x4 vtr(lds_cptr p) { return __builtin_bit_cast(s16x4, __builtin_amdgcn_ds_read_tr16_b64_v4i16((__attribute__((address_space(3))) v4i16_t*)p)); }
__device__ __forceinline__ float msk(float c, unsigned mw, int bit) { const unsigned t = (unsigned)__builtin_amdgcn_sbfe((int)mw, bit, 1); return __uint_as_float((t & __float_as_uint(c)) | (~t & 0xff800000u)); }
__device__ __forceinline__ void pv(f32x16* o, int vb, bf16x8 pa0, bf16x8 pa1, bf16x8 pa2, bf16x8 pa3) {
  #pragma unroll
  for (int d0 = 0; d0 < 2; ++d0) { s16x4 lo[4], hi[4];
    #pragma unroll
    for (int ks = 0; ks < 4; ++ks) {
      asm volatile("ds_read_b64_tr_b16 %0,%1 offset:%c2" : "=&v"(lo[ks]) : "v"(vb), "i"(d0 * 4096 + ks * 1024) : "memory");
      asm volatile("ds_read_b64_tr_b16 %0,%1 offset:%c2" : "=&v"(hi[ks]) : "v"(vb), "i"(d0 * 4096 + ks * 1024 + 512) : "memory"); }
    asm volatile("s_waitcnt lgkmcnt(0)" ::: "memory"); SBAR();
    #define PK(k) (bf16x8){lo[k][0], lo[k][1], lo[k][2], lo[k][3], hi[k][0], hi[k][1], hi[k][2], hi[k][3]}
    o[d0] = __builtin_amdgcn_mfma_f32_32x32x16_bf16(pa0, PK(0), o[d0], 0, 0, 0);
    o[d0] = __builtin_amdgcn_mfma_f32_32x32x16_bf16(pa1, PK(1), o[d0], 0, 0, 0);
    o[d0] = __builtin_amdgcn_mfma_f32_32x32x16_bf16(pa2, PK(2), o[d0], 0, 0, 0);
    o[d0] = __builtin_amdgcn_mfma_f32_32x32x16_bf16(pa3, PK(3), o[d0], 0, 0, 0);
    #undef PK
  }
}

template <int NTW>
__device__ __forceinline__ void topk_stage(char* shm, const bf16* __restrict__ QIB, const bf16* __restrict__ KIB, const float* __restrict__ WI, int b, int i) {
  int tid = threadIdx.x; asm volatile("" : "+v"(tid));
  const int lane = tid & 63, r32 = lane & 31, hi = lane >> 5; const int wid = __builtin_amdgcn_readfirstlane(tid >> 6);
  const size_t rowbase = (size_t)b * SEQ; const int t0 = 32 * i, NT32 = i + 1;
  char* qimg = shm + LDS_QI; int* exi = (int*)(shm + LDS_EX); float* exf = (float*)(shm + LDS_EX + 2048);
  unsigned* maskw = (unsigned*)(shm + LDS_MASK);
  #pragma unroll
  for (int k = 0; k < 2; ++k) { const int p = tid + 512 * k, q = p & 31, c = p >> 5; *(u32x4*)(qimg + p * 16) = *(const u32x4*)(QIB + (rowbase + t0 + q) * 256 + c * 8); }
  const float4 wv = *(const float4*)(WI + (rowbase + t0 + r32) * 4);
  __syncthreads();
  float sc[NTW][16];
  float vmax = -INFINITY, vmin = INFINITY;
  bf16x8 kfr[2][4];
  { const bf16* kp = KIB + (rowbase + 32 * (wid * NTW) + r32) * 64 + hi * 8;
    #pragma unroll
    for (int d0 = 0; d0 < 4; ++d0) kfr[0][d0] = *(const bf16x8*)(kp + d0 * 16); }
  #pragma unroll
  for (int jt = 0; jt < NTW; ++jt) {
    const int tile = wid * NTW + jt;
    if (jt + 1 < NTW) { const bf16* kp = KIB + (rowbase + 32 * (tile + 1) + r32) * 64 + hi * 8;
      #pragma unroll
      for (int d0 = 0; d0 < 4; ++d0) kfr[(jt + 1) & 1][d0] = *(const bf16x8*)(kp + d0 * 16); }
    if (tile < NT32) {
      f32x16 I = f32x16{};
      int qoff = lane * 16; asm volatile("" : "+v"(qoff));
      #pragma unroll
      for (int h = 0; h < 4; ++h) { f32x16 acc = f32x16{};
        #pragma unroll
        for (int d0 = 0; d0 < 4; ++d0) { const bf16x8 qf = *(const bf16x8*)(qimg + (h * 4 + d0) * 1024 + qoff); acc = __builtin_amdgcn_mfma_f32_32x32x16_bf16(kfr[jt & 1][d0], qf, acc, 0, 0, 0); }
        const float w = (h == 0) ? wv.x : (h == 1) ? wv.y : (h == 2) ? wv.z : wv.w;
        #pragma unroll
        for (int r = 0; r < 16; ++r) I[r] += w * fmaxf(acc[r], 0.f); }
      if (tile == i) {
        #pragma unroll
        for (int r = 0; r < 16; ++r) { const bool ok = crow(r, hi) <= r32; sc[jt][r] = ok ? I[r] : -INFINITY; vmax = fmaxf(vmax, sc[jt][r]); vmin = fminf(vmin, ok ? I[r] : INFINITY); }
      } else {
        #pragma unroll
        for (int r = 0; r < 16; ++r) { sc[jt][r] = I[r]; vmax = fmaxf(vmax, I[r]); vmin = fminf(vmin, I[r]); }
      }
    } else {
      #pragma unroll
      for (int r = 0; r < 16; ++r) sc[jt][r] = -INFINITY;
    }
    SBAR();
  }
  vmax = fmaxf(vmax, __shfl_xor(vmax, 32)); vmin = fminf(vmin, __shfl_xor(vmin, 32));
  if (hi == 0) { exf[(r32 * 8 + wid) * 2] = vmax; exf[(r32 * 8 + wid) * 2 + 1] = vmin; }
  __syncthreads();
  #pragma unroll
  for (int w = 0; w < 8; ++w) { vmax = fmaxf(vmax, exf[(r32 * 8 + w) * 2]); vmin = fminf(vmin, exf[(r32 * 8 + w) * 2 + 1]); }
  int par = 0;
  #define COUNT2(a, tot) do { int cge_ = 0, cgt_ = 0; \
    _Pragma("unroll") for (int jt = 0; jt < NTW; ++jt) _Pragma("unroll") for (int r = 0; r < 16; ++r) { cge_ += (sc[jt][r] >= (a)) ? 1 : 0; cgt_ += (sc[jt][r] > (a)) ? 1 : 0; } \
    int pk_ = cge_ | (cgt_ << 16); pk_ += __shfl_xor(pk_, 32); \
    if (hi == 0) exi[par * 256 + r32 * 8 + wid] = pk_; __syncthreads(); \
    tot = 0; _Pragma("unroll") for (int w = 0; w < 8; ++w) tot += exi[par * 256 + r32 * 8 + w]; par ^= 1; } while (0)
  #define COUNT1(a, tot) do { int cge_ = 0; \
    _Pragma("unroll") for (int jt = 0; jt < NTW; ++jt) _Pragma("unroll") for (int r = 0; r < 16; ++r) cge_ += (sc[jt][r] >= (a)) ? 1 : 0; \
    cge_ += __shfl_xor(cge_, 32); \
    if (hi == 0) exi[par * 256 + r32 * 8 + wid] = cge_; __syncthreads(); \
    tot = 0; _Pragma("unroll") for (int w = 0; w < 8; ++w) tot += exi[par * 256 + r32 * 8 + w]; par ^= 1; } while (0)
  const int n = t0 + r32 + 1;
  bool done = (n <= TOPK); float T = done ? -3.0e38f : 0.f; int rneed = 0x7fffffff;
  float lo = 0.f, hi_ = 0.f; int clo = 0, chi = 0;
  { int tot; COUNT2(0.f, tot); const int tge = tot & 0xffff, tgt = tot >> 16;
    if (!done) {
      if (tgt <= TOPK && TOPK <= tge) { done = true; T = 0.f; rneed = TOPK - tgt; }
      else if (tgt > TOPK) { lo = 0.f; clo = tgt; hi_ = __uint_as_float(__float_as_uint(vmax) + 1u); chi = 0; }
      else { hi_ = 0.f; chi = tge; lo = vmin; clo = n; } } }
  for (int it = 0; it < 400; ++it) {
    if (__all(done)) break;
    const float w = hi_ - lo, mid = lo + 0.5f * w;
    const float xi = hi_ - w * (((float)(TOPK - chi) + 0.5f) * __builtin_amdgcn_rcpf((float)(clo - chi) + 1.0f));
    const bool bis = ((it % 3) == 2) || !(xi > lo && xi < hi_);
    const float x = bis ? mid : xi;
    if (!done && !(x > lo && x < hi_)) { done = true; T = lo; rneed = TOPK - chi; }
    int tot; COUNT1(x, tot);
    if (!done) { if (tot == TOPK) { done = true; T = x; rneed = 0x7fffffff; } else if (tot > TOPK) { lo = x; clo = tot; } else { hi_ = x; chi = tot; } }
  }
  if (!done) { T = lo; rneed = TOPK - chi; }
  #undef COUNT1
  #undef COUNT2
  unsigned gtw[NTW], eqw[NTW], oth[NTW]; int et[NTW]; int wtot = 0;
  #pragma unroll
  for (int jt = 0; jt < NTW; ++jt) { unsigned g = 0u, e = 0u;
    #pragma unroll
    for (int r = 15; r >= 0; --r) { g = g * 2u + ((sc[jt][r] > T) ? 1u : 0u); e = e * 2u + ((sc[jt][r] == T) ? 1u : 0u); }
    gtw[jt] = g; eqw[jt] = e; oth[jt] = (unsigned)__shfl_xor((int)e, 32); et[jt] = __popc(e) + __popc(oth[jt]); wtot += et[jt]; }
  if (hi == 0) exi[512 + r32 * 8 + wid] = wtot;
  __syncthreads();
  int ebefore = 0;
  #pragma unroll
  for (int w = 0; w < 8; ++w) ebefore += (w < wid) ? exi[512 + r32 * 8 + w] : 0;
  #pragma unroll
  for (int jt = 0; jt < NTW; ++jt) {
    unsigned take = (rneed >= ebefore + et[jt]) ? 0xffffu : 0u;
    const bool straddle = (rneed > ebefore) && (rneed < ebefore + et[jt]);
    if (__any(straddle)) { unsigned tk = 0u; int hi2 = hi; asm volatile("" : "+v"(hi2));
      #pragma unroll
      for (int r = 0; r < 16; ++r) { const int g = r >> 2; const int pfx = ebefore + __popc(eqw[jt] & ((1u << r) - 1u)) + __popc(oth[jt] & ((1u << (4 * (g + hi2))) - 1u)); tk |= (pfx < rneed) ? (1u << r) : 0u; }
      take = straddle ? tk : take; }
    const unsigned m = gtw[jt] | (eqw[jt] & take);
    ebefore += et[jt];
    if (jt & 1) { const unsigned m0 = gtw[jt - 1]; maskw[((wid * NTW + jt) >> 1) * 64 + lane] = m0 | (m << 16); } else gtw[jt] = m;
  }
  __syncthreads();
}

template <int THRL> __device__ __forceinline__ void attn_unit(int b, int i, const bf16* Q, const bf16* __restrict__ K, const bf16* __restrict__ V, const bf16* __restrict__ GA, bf16* Y, char* shm) {
  int tid = threadIdx.x; asm volatile("" : "+v"(tid));
  const int lane = tid & 63, r32 = lane & 31, hi = lane >> 5; const int wid = __builtin_amdgcn_readfirstlane(tid >> 6);
  const long rowbase = (long)b * SEQ; const int t0 = 32 * i;
  const int NTr = (i >> 1) + 1; int NT = NTr + (NTr & 1); NT = NT < 4 ? 4 : NT;
  const float slope2 = __builtin_amdgcn_exp2f(-(float)(wid + 1)) * 1.4426950408889634f;
  const float sl32 = 32.f * slope2, sl64 = 64.f * slope2;
  const bf16* Qw = Q + (rowbase + t0) * 512 + wid * 64;
  const unsigned lds0 = (unsigned)(uintptr_t)shm;
  float* wsf = (float*)(shm + LDS_WS) + wid * 64;
  const unsigned* maskw = (const unsigned*)(shm + LDS_MASK);
  const bf16* ksrc = K + (rowbase + lane) * 64 + wid * 8;
  const bf16* vsrc = V + (rowbase + 16 * (wid & 3) + (lane >> 2)) * 64 + (wid >> 2) * 32 + (lane & 3) * 8;
  const unsigned kdst = lds0 + LDS_K + wid * 1024, vdst = lds0 + LDS_V + wid * 1024;
  #define DMA_K(t, slot) glds16(ksrc + (long)(t) * KVBLK * 64, (unsigned)__builtin_amdgcn_readfirstlane(kdst + (slot)))
  #define DMA_V(t, slot) glds16(vsrc + (long)(t) * KVBLK * 64, (unsigned)__builtin_amdgcn_readfirstlane(vdst + (slot)))
  const int vb0 = (int)(lds0 + LDS_V) + ((lane >> 4) & 1) * 32 + (lane & 3) * 8 + (4 * hi + ((lane & 15) >> 2)) * 64;
  const char* Kbase = shm + LDS_K; bf16x8 kf[8];
  const lds_cptr shm3 = (lds_cptr)shm; const lds_cptr kp0 = shm3 + LDS_K + hi * 1024 + r32 * 16; const lds_cptr vp0 = shm3 + LDS_V + ((lane >> 4) & 1) * 32 + (lane & 3) * 8 + (4 * hi + ((lane & 15) >> 2)) * 64;
  DMA_K(0, 0); DMA_V(0, 0); DMA_K(1, SLOTB);
  bf16x8 qr[4];
  #pragma unroll
  for (int d0 = 0; d0 < 4; ++d0) qr[d0] = *reinterpret_cast<const bf16x8*>(&Qw[(long)r32 * 512 + d0 * 16 + hi * 8]);
  float mhat = 0.f, l_reg = 0.f; f32x16 o[2]; o[0] = f32x16{}; o[1] = f32x16{};
  f32x16 negm;
  #pragma unroll
  for (int r = 0; r < 16; ++r) negm[r] = slope2 * (float)((r & 3) + 8 * (r >> 2) + 4 * hi);
  asm volatile("" : "+v"(negm));
  #define CMASK(P0, P1, t, mw) do { _Pragma("unroll") for (int r = 0; r < 16; ++r) { P0[r] = msk(P0[r], (mw), r); P1[r] = msk(P1[r], (mw), 16 + r); } } while (0)
  bool resc = false;
  #define RESC() do { if (resc) { asm volatile("s_waitcnt lgkmcnt(0)" ::: "memory"); \
      _Pragma("unroll") for (int d_ = 0; d_ < 2; ++d_) _Pragma("unroll") for (int r = 0; r < 16; ++r) o[d_][r] *= wsf[crow(r, hi)]; } } while (0)
  f32x16 pA0, pA1, pB0, pB1;
  int sl_prev = 0, sl_cur = 0, sl_next = SLOTB;
  #define ROT() do { sl_prev = sl_cur; sl_cur = sl_next; sl_next = (sl_next == (NSLOT - 1) * SLOTB) ? 0 : sl_next + SLOTB; } while (0)
  DMA_K(2, 2 * SLOTB);
  WAIT_BAR(3);
  { const char* kb = Kbase + hi * 1024 + r32 * 16;
    #pragma unroll
    for (int d0 = 0; d0 < 4; ++d0) {
      const bf16x8 b0 = *reinterpret_cast<const bf16x8*>(kb + d0 * 2048);
      const bf16x8 b1 = *reinterpret_cast<const bf16x8*>(kb + d0 * 2048 + 512);
      if (d0 == 0) { pA0 = __builtin_amdgcn_mfma_f32_32x32x16_bf16(b0, qr[0], negm, 0, 0, 0); pA1 = __builtin_amdgcn_mfma_f32_32x32x16_bf16(b1, qr[0], negm, 0, 0, 0); }
      else { pA0 = __builtin_amdgcn_mfma_f32_32x32x16_bf16(b0, qr[d0], pA0, 0, 0, 0); pA1 = __builtin_amdgcn_mfma_f32_32x32x16_bf16(b1, qr[d0], pA1, 0, 0, 0); } }
    asm volatile("s_nop 15\n\ts_nop 7" : "+v"(pA0), "+v"(pA1));
    const unsigned mw = maskw[lane];
    #pragma unroll
    for (int r = 0; r < 16; ++r) pA1[r] = fadd_s(pA1[r], sl32);
    CMASK(pA0, pA1, 0, mw);
    float rm = pA0[0];
    #pragma unroll
    for (int r = 1; r < 16; ++r) rm = __builtin_fmaxf(rm, pA0[r]);
    #pragma unroll
    for (int r = 0; r < 16; ++r) rm = __builtin_fmaxf(rm, pA1[r]);
    { auto rr = __builtin_amdgcn_permlane32_swap(__float_as_uint(rm), __float_as_uint(rm), false, false); rm = __builtin_fmaxf(__uint_as_float(rr[0]), __uint_as_float(rr[1])); }
    const float dl = (rm > -INFINITY) ? rm : 0.f; mhat = fadd_s(mhat, dl);
    #pragma unroll
    for (int r = 0; r < 16; ++r) { pA0[r] = fsub_s(pA0[r], dl); pA1[r] = fsub_s(pA1[r], dl); }
    { const float adj = sl64 - dl;
      #pragma unroll
      for (int r = 0; r < 16; ++r) negm[r] += adj;
      asm volatile("" : "+v"(negm)); }
    #pragma unroll
    for (int r = 0; r < 16; ++r) { pA0[r] = __builtin_amdgcn_exp2f(pA0[r]); pA1[r] = __builtin_amdgcn_exp2f(pA1[r]); }
  }
  WAIT_BAR(0);
  DMA_K(3, 0); DMA_V(1, SLOTB);
  ROT();
  kload8(kf, kp0 + sl_cur);
  WAIT_BAR(2);
  s16x4 vlo[8], vhi[8]; u32x4 pw0, pw1, pw2, pw3;
  #define PKW(P, B) cvtpk_s(P[B], P[B + 1])
  #define PAF(k) __builtin_bit_cast(bf16x8, pw##k)
  #define VFR(i) (bf16x8){vlo[i][0], vlo[i][1], vlo[i][2], vlo[i][3], vhi[i][0], vhi[i][1], vhi[i][2], vhi[i][3]}
  #define PIN(x) asm volatile("" : "+v"(x))
  #define MX3(a, b, c) __builtin_fmaxf(__builtin_fmaxf((a), (b)), (c))
  #define GAPA(MF, A0, A1, A2, A3, W0, W1, PW) do { MF; sacc += A0; sacc += A1; sacc += A2; sacc += A3; PIN(sacc); W0; W1; PIN(PW); SBAR(); } while (0)
  #define EXM(v, bit) __builtin_amdgcn_exp2f(v)
  #define GAPB(MF, X, B, MB) do { MF; X[B] = EXM(X[B], (MB) + (B)); X[B + 1] = EXM(X[B + 1], (MB) + (B) + 1); X[B + 2] = EXM(X[B + 2], (MB) + (B) + 2); X[B + 3] = EXM(X[B + 3], (MB) + (B) + 3); PIN(X); SBAR(); } while (0)
  #define VRD(i) do { vlo[i] = vtr(vp_ + (((i) >> 2) * 4096 + ((i) & 3) * 1024)); vhi[i] = vtr(vp_ + (((i) >> 2) * 4096 + ((i) & 3) * 1024 + 512)); } while (0)
  #define KRD(G, j) do { if (G) { kload2(kf, kp0 + sl_next, j); SBAR(); } } while (0)
  #define STEP(C0, C1, P0, P1, t, GK, GV, GL) do { SBAR(); \
    const lds_cptr vp_ = vp0 + sl_prev; const unsigned mw_ = maskw[(t) * 64 + lane]; \
    VRD(0); SBAR(); float sacc = (P0[0] + P0[1]); \
    GAPA(C0 = __builtin_amdgcn_mfma_f32_32x32x16_bf16(kf[0], qr[0], negm, 0, 0, 0), P0[2], P0[3], P0[4], P0[5],     pw0[0] = PKW(P0, 0), pw0[1] = PKW(P0, 2), pw0); \
    VRD(4); SBAR(); GAPA(C1 = __builtin_amdgcn_mfma_f32_32x32x16_bf16(kf[1], qr[0], negm, 0, 0, 0), P0[6], P0[7], P0[8], P0[9],     pw0[2] = PKW(P0, 4), pw0[3] = PKW(P0, 6), pw0); \
    VRD(1); SBAR(); GAPA(C0 = __builtin_amdgcn_mfma_f32_32x32x16_bf16(kf[2], qr[1], C0, 0, 0, 0),   P0[10], P0[11], P0[12], P0[13], pw1[0] = PKW(P0, 8), pw1[1] = PKW(P0, 10), pw1); \
    VRD(5); SBAR(); GAPA(C1 = __builtin_amdgcn_mfma_f32_32x32x16_bf16(kf[3], qr[1], C1, 0, 0, 0),   P0[14], P0[15], P1[0], P1[1],   pw1[2] = PKW(P0, 12), pw1[3] = PKW(P0, 14), pw1); \
    VRD(2); SBAR(); GAPA(C0 = __builtin_amdgcn_mfma_f32_32x32x16_bf16(kf[4], qr[2], C0, 0, 0, 0),   P1[2], P1[3], P1[4], P1[5],     pw2[0] = PKW(P1, 0), pw2[1] = PKW(P1, 2), pw2); \
    VRD(6); SBAR(); GAPA(C1 = __builtin_amdgcn_mfma_f32_32x32x16_bf16(kf[5], qr[2], C1, 0, 0, 0),   P1[6], P1[7], P1[8], P1[9],     pw2[2] = PKW(P1, 4), pw2[3] = PKW(P1, 6), pw2); \
    VRD(3); SBAR(); GAPA(C0 = __builtin_amdgcn_mfma_f32_32x32x16_bf16(kf[6], qr[3], C0, 0, 0, 0),   P1[10], P1[11], P1[12], P1[13], pw3[0] = PKW(P1, 8), pw3[1] = PKW(P1, 10), pw3); \
    VRD(7); SBAR(); GAPA(C1 = __builtin_amdgcn_mfma_f32_32x32x16_bf16(kf[7], qr[3], C1, 0, 0, 0),   P1[14], P1[15], 0.f, 0.f,       pw3[2] = PKW(P1, 12), pw3[3] = PKW(P1, 14), pw3); \
    l_reg += sacc; \
    if (GK) { DMA_K((t) + 3, sl_cur); } if (GV) { DMA_V((t) + 1, sl_next); } \
    _Pragma("unroll") for (int r = 0; r < 16; ++r) C1[r] += sl32; \
    CMASK(C0, C1, t, mw_); \
    { float a = MX3(C0[0], C0[1], C1[0]), b_ = MX3(C0[2], C0[3], C1[1]); a = MX3(a, C1[2], C1[3]); \
      _Pragma("unroll") for (int r = 4; r < 16; r += 4) { a = MX3(a, C0[r], C0[r + 1]); b_ = MX3(b_, C0[r + 2], C0[r + 3]); a = MX3(a, C1[r], C1[r + 1]); b_ = MX3(b_, C1[r + 2], C1[r + 3]); } \
      float rm = __builtin_fmaxf(a, b_); { auto rr = __builtin_amdgcn_permlane32_swap(__float_as_uint(rm), __float_as_uint(rm), false, false); rm = __builtin_fmaxf(__uint_as_float(rr[0]), __uint_as_float(rr[1])); } \
      resc = false; float adj = sl64; const bool unset = (l_reg == 0.f);     \
      if (__builtin_expect(__any((rm > (float)THRL) || (unset && rm > -INFINITY)), 0)) { const float dl = unset ? ((rm > -INFINITY) ? rm : 0.f) : __builtin_fmaxf(rm, 0.f); mhat += dl; adj -= dl; \
        _Pragma("unroll") for (int r = 0; r < 16; ++r) { C0[r] -= dl; C1[r] -= dl; } \
        const float f = unset ? 1.0f : __builtin_amdgcn_exp2f(-dl); l_reg *= f; if (hi == 0) wsf[r32] = f; resc = true; } \
      _Pragma("unroll") for (int r = 0; r < 16; ++r) negm[r] += adj; asm volatile("" : "+v"(negm)); } \
    SBAR(); \
    GAPB(o[0] = __builtin_amdgcn_mfma_f32_32x32x16_bf16(PAF(0), VFR(0), o[0], 0, 0, 0), C0, 0, 0); \
    GAPB(o[1] = __builtin_amdgcn_mfma_f32_32x32x16_bf16(PAF(0), VFR(4), o[1], 0, 0, 0), C0, 4, 0); \
    KRD(GL, 0); GAPB(o[0] = __builtin_amdgcn_mfma_f32_32x32x16_bf16(PAF(1), VFR(1), o[0], 0, 0, 0), C0, 8, 0); \
    KRD(GL, 1); GAPB(o[1] = __builtin_amdgcn_mfma_f32_32x32x16_bf16(PAF(1), VFR(5), o[1], 0, 0, 0), C0, 12, 0); \
    KRD(GL, 2); GAPB(o[0] = __builtin_amdgcn_mfma_f32_32x32x16_bf16(PAF(2), VFR(2), o[0], 0, 0, 0), C1, 0, 16); \
    KRD(GL, 3); GAPB(o[1] = __builtin_amdgcn_mfma_f32_32x32x16_bf16(PAF(2), VFR(6), o[1], 0, 0, 0), C1, 4, 16); \
    GAPB(o[0] = __builtin_amdgcn_mfma_f32_32x32x16_bf16(PAF(3), VFR(3), o[0], 0, 0, 0), C1, 8, 16); \
    GAPB(o[1] = __builtin_amdgcn_mfma_f32_32x32x16_bf16(PAF(3), VFR(7), o[1], 0, 0, 0), C1, 12, 16); \
    } while (0)
  int t = 1;
  for (; t + 5 < NT; t += 2) {
    STEP(pB0, pB1, pA0, pA1, t, true, true, true);       WAIT_BAR(2); RESC(); ROT();
    STEP(pA0, pA1, pB0, pB1, t + 1, true, true, true);   WAIT_BAR(2); RESC(); ROT();
  }
  #define ENDW(tt) do { if ((tt) + 3 < NT) { WAIT_BAR(2); } else if ((tt) + 2 < NT) { WAIT_BAR(1); } else { WAIT_BAR(0); } } while (0)
  for (; t + 1 < NT; t += 2) {
    STEP(pB0, pB1, pA0, pA1, t, (t + 3 < NT), (t + 1 < NT), (t + 1 < NT));         ENDW(t);     RESC(); ROT();
    STEP(pA0, pA1, pB0, pB1, t + 1, (t + 4 < NT), (t + 2 < NT), (t + 2 < NT));     ENDW(t + 1); RESC(); ROT();
  }
  STEP(pB0, pB1, pA0, pA1, NT - 1, false, false, false); RESC();
  { float sacc = pB0[0] + pB0[1]; _Pragma("unroll") for (int r = 2; r < 16; ++r) sacc += pB0[r]; _Pragma("unroll") for (int r = 0; r < 16; ++r) sacc += pB1[r]; l_reg += sacc;
    pw0 = (u32x4){PKW(pB0, 0), PKW(pB0, 2), PKW(pB0, 4), PKW(pB0, 6)}; pw1 = (u32x4){PKW(pB0, 8), PKW(pB0, 10), PKW(pB0, 12), PKW(pB0, 14)}; pw2 = (u32x4){PKW(pB1, 0), PKW(pB1, 2), PKW(pB1, 4), PKW(pB1, 6)}; pw3 = (u32x4){PKW(pB1, 8), PKW(pB1, 10), PKW(pB1, 12), PKW(pB1, 14)};
    SBAR(); pv(o, vb0 + sl_cur, PAF(0), PAF(1), PAF(2), PAF(3)); }
  #undef PKW
  #undef PAF
  #undef VFR
  #undef PIN
  #undef MX3
  #undef GAPA
  #undef GAPB
  #undef EXM
  #undef VRD
  #undef KRD
  #undef STEP
  #undef ENDW
  { auto rr = __builtin_amdgcn_permlane32_swap(__float_as_uint(l_reg), __float_as_uint(l_reg), false, false); l_reg = __uint_as_float(rr[0]) + __uint_as_float(rr[1]); }
  if (hi == 0) wsf[32 + r32] = l_reg; asm volatile("s_waitcnt lgkmcnt(0)" ::: "memory");
  float rli[16];
  #pragma unroll
  for (int r = 0; r < 16; ++r) rli[r] = __builtin_amdgcn_rcpf(wsf[32 + crow(r, hi)]);
  { bf16* stg = (bf16*)(shm + LDS_OST) + wid * 2048;
    #pragma unroll
    for (int r = 0; r < 16; ++r) { const int orow = crow(r, hi);
      #pragma unroll
      for (int d0 = 0; d0 < 2; ++d0) stg[orow * 64 + d0 * 32 + r32] = (bf16)(cvtpk_s(o[d0][r] * rli[r], 0.f) & 0xffffu); }
    asm volatile("s_waitcnt lgkmcnt(0)" ::: "memory");
    #pragma unroll
    for (int ii = 0; ii < 4; ++ii) { const int row = ii * 8 + (lane >> 3), ch = lane & 7; const u32x4 v = *(const u32x4*)(stg + row * 64 + ch * 8);
      const u32x4 g = *(const u32x4*)(GA + (rowbase + t0 + row) * 512 + wid * 64 + ch * 8);
      u32x4 w;
      w.x = cvtpk_s(__uint_as_float(v.x << 16) * __uint_as_float(g.x << 16), __uint_as_float(v.x & 0xffff0000u) * __uint_as_float(g.x & 0xffff0000u));
      w.y = cvtpk_s(__uint_as_float(v.y << 16) * __uint_as_float(g.y << 16), __uint_as_float(v.y & 0xffff0000u) * __uint_as_float(g.y & 0xffff0000u));
      w.z = cvtpk_s(__uint_as_float(v.z << 16) * __uint_as_float(g.z << 16), __uint_as_float(v.z & 0xffff0000u) * __uint_as_float(g.z & 0xffff0000u));
      w.w = cvtpk_s(__uint_as_float(v.w << 16) * __uint_as_float(g.w << 16), __uint_as_float(v.w & 0xffff0000u) * __uint_as_float(g.w & 0xffff0000u));
      *(u32x4*)(Y + (rowbase + t0 + row) * 1024 + wid * 64 + ch * 8) = w; } }
  asm volatile("s_waitcnt lgkmcnt(0)\n\ts_barrier" ::: "memory");
  #undef DMA_K
  #undef DMA_V
  #undef CMASK
  #undef RESC
  #undef ROT
}
__device__ __forceinline__ void unit(char* shm, const bf16* QB, const bf16* KB, const bf16* VB, const bf16* GAB, const bf16* QIB, const bf16* KIB, const float* WI, bf16* Y, int b, int i) {
  const int ntw = (i + 8) >> 3;
#if defined(TOPK_ONLY)
  topk_stage<TOPK_ONLY>(shm, QIB, KIB, WI, b, i);
#elif !defined(ATT_NO_TOPK)
  if (ntw <= 2) topk_stage<2>(shm, QIB, KIB, WI, b, i);
  else if (ntw <= 4) topk_stage<4>(shm, QIB, KIB, WI, b, i);
  else if (ntw <= 6) topk_stage<6>(shm, QIB, KIB, WI, b, i);
  else topk_stage<8>(shm, QIB, KIB, WI, b, i);
#endif
#if !defined(ATT_NO_ATTN)
  attn_unit<8>(b, i, QB, KB, VB, GAB, Y, shm);
#endif
}
#undef SBAR
#undef WAIT_BAR
}

constexpr int NWAVES = 8;
#ifndef MK_N_LAUNCHES
#define MK_N_LAUNCHES 1
#endif
constexpr int NPHASE = 7;
constexpr int N_LAUNCHES = MK_N_LAUNCHES;
static_assert(N_LAUNCHES == 1 || N_LAUNCHES == NPHASE, "MK_N_LAUNCHES is 1 or 7");
constexpr int BATCH = 8, SEQ = 2048, D = 1024, M = BATCH * SEQ;
constexpr int NIN = 3072, NIN_ORIG = 3012, DH = 512;
constexpr int CONVW = 31, TOPK = 256;
constexpr float EPS = 1e-6f;
constexpr float C2 = 0.125f * 1.4426950408889634f;

constexpr size_t MiB = 1u << 20;
constexpr size_t WS_CTL = 0, CTL_ZERO_BYTES = 1 * MiB;
constexpr size_t WS_MOD = 1 * MiB;
constexpr size_t WS_WIN = 2 * MiB;
constexpr size_t WS_WPW = 8 * MiB;
constexpr size_t WS_WOUT = 9 * MiB;
constexpr size_t WS_X = 11 * MiB;
constexpr size_t WS_HB = 16 * MiB;
constexpr size_t WS_QB = 48 * MiB;
constexpr size_t WS_GAB = 64 * MiB;
constexpr size_t WS_QIB = 80 * MiB;
constexpr size_t WS_KB = 88 * MiB, WS_VB = 90 * MiB, WS_KIB = 92 * MiB;
constexpr size_t WS_WI = 94 * MiB;
constexpr size_t WS_UB = 96 * MiB;
constexpr size_t WS_GCB = 112 * MiB;
constexpr size_t WS_A2B = 128 * MiB;
constexpr size_t WS_YCAT = 144 * MiB;
constexpr size_t WS_YF = 176 * MiB;
constexpr size_t WS_END = 240 * MiB;
constexpr int CW_TMO = 0, CW_CODE = 1, CW_BAR = 4096, CW_SEAM = 16384;

constexpr int RING_OFF = 0, RING_BYTES = 131072;
constexpr int LDSCTL_OFF = RING_BYTES, MISC_OFF = LDSCTL_OFF + 320;
constexpr int LDS_BYTES = 147456;

__host__ __device__ __forceinline__ int win_orig_col(int n) {
    const int pn = n >> 8, c = n & 255;
    if (pn < 2) return n;
    if (pn < 4) return 640 + (n - 512);
    if (pn == 4) return 1152 + c;
    if (pn == 5) { if (c < 64) return 512 + c; if (c < 128) return 576 + (c - 64); if (c < 192) return 1408 + (c - 128); if (c < 196) return 1472 + (c - 192); return -1; }
    if (pn < 10) { const int j = pn - 6; return c < 128 ? 1476 + 128 * j + c : 1988 + 128 * j + (c - 128); }
    return 2500 + (n - 2560);
}

struct Frame {
    LAS unsigned char* lds;
    volatile LAS unsigned* MISC;
    gu32* ctl;
    int tid, lane, wave, vcu, G;
    const float *x, *c, *w_ada, *b_ada, *g_pre, *w_in, *w_dw, *b_dw, *g_cn, *b_cn, *w_pw2, *b_pw2, *w_out, *g_post;
    float* out;
    float *MOD, *WI, *YF;
    bf16 *WIN, *WPW, *WOUT, *HB, *QB, *GAB, *QIB, *KB, *VB, *KIB, *UB, *GCB, *A2B, *YCAT;
};

template <bool MAPPED>
__device__ __forceinline__ void p0_transpose_item(const float* W, int K, int ldw, bf16* WT, LAS float* scr, int item, int nblk, int lane) {
    const int kb = item / nblk, nb = item % nblk, k0 = 64 * kb, n0 = 32 * nb;
    const int oc = MAPPED ? win_orig_col(n0 + (lane & 31)) : (n0 + (lane & 31));
#pragma unroll 8
    for (int i = 0; i < 32; ++i) { const int kk = 2 * i + (lane >> 5); scr[kk * 33 + (lane & 31)] = (oc >= 0) ? W[(size_t)(k0 + kk) * ldw + oc] : 0.f; }
    LDS_WAIT(); asm volatile("" ::: "memory");
    const int c = lane & 7;
#pragma unroll
    for (int j = 0; j < 4; ++j) { const int n = (lane >> 3) + 8 * j; const LAS float* s = scr + (8 * c) * 33 + n;
        v4u o; o.x = pk2(s[0 * 33], s[1 * 33]); o.y = pk2(s[2 * 33], s[3 * 33]); o.z = pk2(s[4 * 33], s[5 * 33]); o.w = pk2(s[6 * 33], s[7 * 33]);
        *(GAS v4u*)(WT + (size_t)(n0 + n) * K + k0 + 8 * c) = o; }
    LDS_WAIT(); asm volatile("" ::: "memory");
}
__device__ __forceinline__ float silu_d(float x) { return x / (1.0f + __expf(-x)); }

__device__ __forceinline__ void p0_prologue(Frame& F) {
    LAS float* scr = (LAS float*)(F.lds + RING_OFF + F.wave * 16384);
    const int gw = F.vcu * NWAVES + F.wave, NGW = F.G * NWAVES;
    constexpr int I_IN = (D / 64) * (NIN / 32), I_PW = (DH / 64) * (DH / 32), I_OUT = (D / 64) * (D / 32);
    constexpr int NITEMS = I_IN + I_PW + I_OUT;
    for (int it = gw; it < NITEMS; it += NGW) {
        int r = it;
        if (r < I_IN) { p0_transpose_item<true>(F.w_in, D, NIN_ORIG, F.WIN, scr, r, NIN / 32, F.lane); continue; } r -= I_IN;
        if (r < I_PW) { p0_transpose_item<false>(F.w_pw2, DH, DH, F.WPW, scr, r, DH / 32, F.lane); continue; } r -= I_PW;
        p0_transpose_item<false>(F.w_out, D, D, F.WOUT, scr, r, D / 32, F.lane);
    }
    __syncthreads();
    if (F.vcu < 192) {
        LAS float* sc = (LAS float*)(F.lds + RING_OFF);
        LAS float* part = (LAS float*)(F.lds + RING_OFF + 32768);
        for (int i = F.tid; i < BATCH * D; i += NWAVES * 64) sc[i] = silu_d(F.c[i]);
        __syncthreads();
        const int j0 = 16 * F.vcu, c4 = F.tid & 3, kr = F.tid >> 2;
        f32x4 acc[8];
#pragma unroll
        for (int b = 0; b < 8; ++b) acc[b] = (f32x4){0.f, 0.f, 0.f, 0.f};
#pragma unroll
        for (int r = 0; r < 8; ++r) { const int i = kr * 8 + r; const f32x4 w = *(const GAS f32x4*)(F.w_ada + (size_t)i * (3 * D) + j0 + 4 * c4);
#pragma unroll
            for (int b = 0; b < 8; ++b) acc[b] += w * sc[b * D + i]; }
#pragma unroll
        for (int b = 0; b < 8; ++b)
#pragma unroll
            for (int e = 0; e < 4; ++e) { float v = acc[b][e]; v += __shfl_xor(v, 4); v += __shfl_xor(v, 8); v += __shfl_xor(v, 16); v += __shfl_xor(v, 32); acc[b][e] = v; }
        if (F.lane < 4) {
#pragma unroll
            for (int b = 0; b < 8; ++b)
#pragma unroll
                for (int e = 0; e < 4; ++e) part[F.wave * 128 + b * 16 + 4 * F.lane + e] = acc[b][e];
        }
        __syncthreads();
        if (F.tid < 128) { const int b = F.tid >> 4, col = F.tid & 15; float s = F.b_ada[j0 + col];
#pragma unroll
            for (int w = 0; w < 8; ++w) s += part[w * 128 + b * 16 + col];
            F.MOD[b * (3 * D) + j0 + col] = s; }
        __syncthreads();
    }
}

__device__ __forceinline__ void p1_rows(Frame& F) {
    const int gw = F.vcu * NWAVES + F.wave, NGW = F.G * NWAVES;
    for (int m = gw; m < M; m += NGW) {
        const int b = m / SEQ;
        const GAS f32x4* xr = (const GAS f32x4*)(F.x + (size_t)m * D) + F.lane;
        f32x4 v[4]; float s = 0.f;
#pragma unroll
        for (int j = 0; j < 4; ++j) { v[j] = xr[64 * j]; s += (v[j].x * v[j].x + v[j].y * v[j].y) + (v[j].z * v[j].z + v[j].w * v[j].w); }
        const float rstd = 1.0f / sqrtf(wave_sum(s) * (1.f / D) + EPS);
        GAS unsigned long long* o8 = (GAS unsigned long long*)(F.HB + (size_t)m * D) + F.lane;
#pragma unroll
        for (int j = 0; j < 4; ++j) { const int col = 4 * (F.lane + 64 * j);
            const f32x4 g = *(const GAS f32x4*)(F.g_pre + col), sh = *(const GAS f32x4*)(F.MOD + b * (3 * D) + col), scl = *(const GAS f32x4*)(F.MOD + b * (3 * D) + D + col);
            const f32x4 h = v[j] * rstd * g * (scl + 1.0f) + sh;
            o8[64 * j] = (unsigned long long)pk2(h.x, h.y) | ((unsigned long long)pk2(h.z, h.w) << 32); }
    }
}

__device__ __forceinline__ unsigned fkey(float f) { f += 0.0f; const unsigned u = __float_as_uint(f); return (u & 0x80000000u) ? ~u : (u | 0x80000000u); }
__device__ __forceinline__ int wave_cnt(bool p) { return __popcll(__ballot(p)); }
__device__ __forceinline__ int lane_prefix(bool p, int lane) { const unsigned long long m = __ballot(p); return __popcll(m & ((1ull << lane) - 1ull)); }

__device__ __forceinline__ void attn_naive_unit(Frame& F, int row) {
    LAS float* qi = (LAS float*)(F.lds + RING_OFF);
    LAS float* qh = (LAS float*)(F.lds + RING_OFF + 1024);
    LAS int* selidx = (LAS int*)(F.lds + RING_OFF + 3072);
    LAS int* red = (LAS int*)(F.lds + RING_OFF + 4096);
    LAS float* pb = (LAS float*)(F.lds + RING_OFF + 8192);
    const int b = row / SEQ, t = row % SEQ, n = t + 1, tid = F.tid, lane = F.lane, wave = F.wave;
    if (tid < 256) qi[tid] = bf2f(F.QIB[(size_t)row * 256 + tid]);
    qh[tid] = bf2f(F.QB[(size_t)row * 512 + tid]);
    const f32x4 wv = *(const GAS f32x4*)(F.WI + (size_t)row * 4);
    __syncthreads();
    unsigned key[4]; bool sel[4]; int pos[4];
#pragma unroll
    for (int j = 0; j < 4; ++j) {
        const int s = wave * 256 + 64 * j + lane; key[j] = 0u;
        if (s <= t) {
            const GAS v4u* kr = (const GAS v4u*)(F.KIB + ((size_t)b * SEQ + s) * 64);
            float l0 = 0.f, l1 = 0.f, l2 = 0.f, l3 = 0.f;
#pragma unroll
            for (int c = 0; c < 8; ++c) { const v4u kv = kr[c]; const unsigned kw[4] = {kv.x, kv.y, kv.z, kv.w};
#pragma unroll
                for (int e = 0; e < 4; ++e) { const float k0 = __uint_as_float(kw[e] << 16), k1 = __uint_as_float(kw[e] & 0xffff0000u); const int d = 8 * c + 2 * e;
                    l0 += qi[d] * k0 + qi[d + 1] * k1; l1 += qi[64 + d] * k0 + qi[64 + d + 1] * k1; l2 += qi[128 + d] * k0 + qi[128 + d + 1] * k1; l3 += qi[192 + d] * k0 + qi[192 + d + 1] * k1; } }
            const float scv = wv.x * fmaxf(l0, 0.f) + wv.y * fmaxf(l1, 0.f) + wv.z * fmaxf(l2, 0.f) + wv.w * fmaxf(l3, 0.f);
            key[j] = fkey(scv);
        }
    }
    int nsel;
    if (n <= TOPK) {
        nsel = n;
#pragma unroll
        for (int j = 0; j < 4; ++j) { const int s = wave * 256 + 64 * j + lane; sel[j] = (s <= t); pos[j] = s; }
    } else {
        nsel = TOPK;
        unsigned T = 0u;
        for (int bit = 31; bit >= 0; --bit) {
            const unsigned cand = T | (1u << bit);
            int c = 0;
#pragma unroll
            for (int j = 0; j < 4; ++j) c += wave_cnt(key[j] >= cand);
            if (lane == 0) red[(bit & 1) * 8 + wave] = c;
            __syncthreads();
            int tot = 0;
#pragma unroll
            for (int w = 0; w < 8; ++w) tot += red[(bit & 1) * 8 + w];
            if (tot >= TOPK) T = cand;
        }
        int cg = 0, ce = 0;
#pragma unroll
        for (int j = 0; j < 4; ++j) { cg += wave_cnt(key[j] > T); ce += wave_cnt(key[j] == T); }
        if (lane == 0) { red[16 + wave] = cg; red[24 + wave] = ce; }
        __syncthreads();
        int totg = 0, base_eq = 0;
#pragma unroll
        for (int w = 0; w < 8; ++w) { totg += red[16 + w]; if (w < wave) base_eq += red[24 + w]; }
        const int r = TOPK - totg;
        int run = base_eq, cs = 0;
#pragma unroll
        for (int j = 0; j < 4; ++j) { const bool eq = (key[j] == T); const int my = run + lane_prefix(eq, lane); sel[j] = (key[j] > T) || (eq && my < r); run += wave_cnt(eq); cs += wave_cnt(sel[j]); }
        if (lane == 0) red[32 + wave] = cs;
        __syncthreads();
        int base = 0;
#pragma unroll
        for (int w = 0; w < 8; ++w) if (w < wave) base += red[32 + w];
        run = base;
#pragma unroll
        for (int j = 0; j < 4; ++j) { pos[j] = run + lane_prefix(sel[j], lane); run += wave_cnt(sel[j]); }
    }
#pragma unroll
    for (int j = 0; j < 4; ++j) if (sel[j]) selidx[pos[j]] = wave * 256 + 64 * j + lane;
    __syncthreads();
    const float slope2 = exp2f(-(float)(wave + 1)) * 1.4426950408889634f;
    float sv[4]; float mx = -INFINITY;
#pragma unroll
    for (int j = 0; j < 4; ++j) { const int i = lane + 64 * j; sv[j] = -INFINITY;
        if (i < nsel) { const int s = selidx[i]; const GAS v4u* kr = (const GAS v4u*)(F.KB + ((size_t)b * SEQ + s) * 64); float dot = 0.f;
#pragma unroll
            for (int c = 0; c < 8; ++c) { const v4u kv = kr[c]; const unsigned kw[4] = {kv.x, kv.y, kv.z, kv.w};
#pragma unroll
                for (int e = 0; e < 4; ++e) { const int d = wave * 64 + 8 * c + 2 * e; dot += qh[d] * __uint_as_float(kw[e] << 16) + qh[d + 1] * __uint_as_float(kw[e] & 0xffff0000u); } }
            sv[j] = dot - slope2 * (float)(t - s); }
        mx = fmaxf(mx, sv[j]); }
    mx = wave_max(mx);
    float l = 0.f;
#pragma unroll
    for (int j = 0; j < 4; ++j) { const int i = lane + 64 * j; const float p = (i < nsel) ? exp2f(sv[j] - mx) : 0.f; pb[wave * 256 + i] = p; l += p; }
    l = wave_sum(l);
    __syncthreads();
    float o = 0.f;
    for (int ii = 0; ii < nsel; ++ii) { const int s = selidx[ii]; o += pb[wave * 256 + ii] * bf2f(F.VB[((size_t)b * SEQ + s) * 64 + lane]); }
    o = o / l;
    const float ga = bf2f(F.GAB[(size_t)row * 512 + wave * 64 + lane]);
    F.YCAT[(size_t)row * 1024 + wave * 64 + lane] = (bf16)f2bf(o * ga);
    __syncthreads();
}

__device__ __forceinline__ void conv_naive_unit(Frame& F, int row) {
    LAS float* red = (LAS float*)(F.lds + RING_OFF);
    const int b = row / SEQ, t = row % SEQ, c = F.tid;
    float acc = F.b_dw[c];
    for (int j = 0; j < CONVW; ++j) { const int tt = t - (CONVW - 1) + j; if (tt >= 0) acc += F.w_dw[j * DH + c] * bf2f(F.UB[((size_t)b * SEQ + tt) * DH + c]); }
    const float s = wave_sum(acc);
    if (F.lane == 0) red[F.wave] = s;
    __syncthreads();
    float mean = 0.f;
#pragma unroll
    for (int w = 0; w < 8; ++w) mean += red[w];
    mean *= (1.f / DH);
    const float d = acc - mean; const float q = wave_sum(d * d);
    if (F.lane == 0) red[8 + F.wave] = q;
    __syncthreads();
    float var = 0.f;
#pragma unroll
    for (int w = 0; w < 8; ++w) var += red[8 + w];
    var *= (1.f / DH);
    float y = d * (1.0f / sqrtf(var + EPS)) * F.g_cn[c] + F.b_cn[c];
    y = silu_d(y);
    F.A2B[(size_t)row * DH + c] = (bf16)f2bf(y);
    __syncthreads();
}

__device__ __forceinline__ void p6_rows(Frame& F) {
    const int gw = F.vcu * NWAVES + F.wave, NGW = F.G * NWAVES;
    for (int m = gw; m < M; m += NGW) {
        const int b = m / SEQ;
        const GAS f32x4* yr = (const GAS f32x4*)(F.YF + (size_t)m * D) + F.lane;
        const GAS f32x4* xr = (const GAS f32x4*)(F.x + (size_t)m * D) + F.lane;
        GAS f32x4* orow = (GAS f32x4*)(F.out + (size_t)m * D) + F.lane;
        f32x4 v[4]; float s = 0.f;
#pragma unroll
        for (int j = 0; j < 4; ++j) { v[j] = yr[64 * j]; s += (v[j].x * v[j].x + v[j].y * v[j].y) + (v[j].z * v[j].z + v[j].w * v[j].w); }
        const float rstd = 1.0f / sqrtf(wave_sum(s) * (1.f / D) + EPS);
#pragma unroll
        for (int j = 0; j < 4; ++j) { const int col = 4 * (F.lane + 64 * j);
            const f32x4 g = *(const GAS f32x4*)(F.g_post + col), gt = *(const GAS f32x4*)(F.MOD + b * (3 * D) + 2 * D + col);
            orow[64 * j] = xr[64 * j] + gt * (v[j] * rstd * g); }
    }
}

struct Args { const float* in[14]; float* out; unsigned char* ws; int ph_lo, ph_hi, li, pad; };
__global__ void __launch_bounds__(NWAVES * 64, 2) fwd_kernel(Args args) {
    extern __shared__ __attribute__((aligned(16))) unsigned char lds[];
    Frame F;
    F.lds = (LAS unsigned char*)lds;
    F.MISC = (volatile LAS unsigned*)(F.lds + MISC_OFF);
    F.tid = threadIdx.x; F.lane = F.tid & 63; F.wave = __builtin_amdgcn_readfirstlane(F.tid >> 6);
    F.G = gridDim.x; { const int bx = blockIdx.x; F.vcu = (F.G % 8 == 0) ? (bx % 8) * (F.G / 8) + bx / 8 : bx; }
    unsigned char* ws = args.ws;
    F.ctl = (gu32*)(ws + WS_CTL);
    F.x = args.in[0]; F.c = args.in[1]; F.w_ada = args.in[2]; F.b_ada = args.in[3]; F.g_pre = args.in[4]; F.w_in = args.in[5]; F.w_dw = args.in[6]; F.b_dw = args.in[7];
    F.g_cn = args.in[8]; F.b_cn = args.in[9]; F.w_pw2 = args.in[10]; F.b_pw2 = args.in[11]; F.w_out = args.in[12]; F.g_post = args.in[13]; F.out = args.out;
    F.MOD = (float*)(ws + WS_MOD); F.WI = (float*)(ws + WS_WI); F.YF = (float*)(ws + WS_YF);
    F.WIN = (bf16*)(ws + WS_WIN); F.WPW = (bf16*)(ws + WS_WPW); F.WOUT = (bf16*)(ws + WS_WOUT); F.HB = (bf16*)(ws + WS_HB); F.QB = (bf16*)(ws + WS_QB); F.GAB = (bf16*)(ws + WS_GAB);
    F.QIB = (bf16*)(ws + WS_QIB); F.KB = (bf16*)(ws + WS_KB); F.VB = (bf16*)(ws + WS_VB); F.KIB = (bf16*)(ws + WS_KIB); F.UB = (bf16*)(ws + WS_UB); F.GCB = (bf16*)(ws + WS_GCB);
    F.A2B = (bf16*)(ws + WS_A2B); F.YCAT = (bf16*)(ws + WS_YCAT);
    for (int u = F.tid; u < (LDS_BYTES - LDSCTL_OFF) / 4; u += NWAVES * 64) ((LAS unsigned*)(F.lds + LDSCTL_OFF))[u] = 0u;
    __syncthreads();
    XcdBarrier bar; bar.bar = (unsigned*)(F.ctl + CW_BAR); bar.x = 0; bar.st = nullptr;
    if (N_LAUNCHES == 1) bar = xcd_barrier_post((unsigned*)(F.ctl + CW_BAR), F.MISC + 8);
#define GRID_BAR() do { if (N_LAUNCHES == 1) xcd_barrier(bar); } while (0)
    const int lo = args.ph_lo, hi = args.ph_hi;
#define IN(k) (lo <= (k) && (k) < hi)
#define BOTH(k) (IN(k) && IN((k) + 1))

#define REDERIVE() do { int t_ = threadIdx.x; asm volatile("" : "+v"(t_)); F.tid = t_; F.lane = t_ & 63; } while (0)
    if (IN(0)) { p0_prologue(F); if (BOTH(0)) GRID_BAR(); }
    if (IN(1)) { REDERIVE(); p1_rows(F); if (BOTH(1)) GRID_BAR(); }
    if (IN(2)) {
        REDERIVE();
        pg8::Gemm g{F.HB, F.WIN, M, NIN, D}; pg8::StaticOrder S; S.init(M, NIN, F.G, (int)blockIdx.x);
        pg8::EpiInProj E{{F.QB, F.KB, F.VB, F.GAB, F.QIB, F.KIB, F.UB, F.GCB, F.WI}, C2};
        pg8::gemm_phase<pg8::EpiInProj, pg8::StaticOrder, PG8_ALIGN, PG8_SP2>(F.lds + RING_OFF, g, S, E);
        if (BOTH(2)) GRID_BAR();
    }
    if (IN(3)) {
        REDERIVE();
        for (int row = F.vcu; row < M; row += F.G) conv_naive_unit(F, row);
#if defined(ATTN_NAIVE)
        for (int row = F.vcu; row < M; row += F.G) attn_naive_unit(F, row);
#else
        for (int pu = F.vcu; pu < BATCH * 32; pu += F.G) { const int b = pu >> 5, s = pu & 31;
            for (int k = 0; k < 2; ++k) att::unit((char*)lds + RING_OFF, F.QB, F.KB, F.VB, F.GAB, F.QIB, F.KIB, F.WI, F.YCAT, b, k ? s : 63 - s); }
#endif
        if (BOTH(3)) GRID_BAR();
    }
    if (IN(4)) {
        REDERIVE();
        pg8::Gemm g{F.A2B, F.WPW, M, DH, DH}; pg8::StaticOrder S; S.init(M, DH, F.G, (int)blockIdx.x);
        pg8::EpiPw2 E{F.b_pw2, F.GCB, F.YCAT};
        pg8::gemm_phase<pg8::EpiPw2, pg8::StaticOrder, PG8_ALIGN, PG8_SP2>(F.lds + RING_OFF, g, S, E);
        if (BOTH(4)) GRID_BAR();
    }
    if (IN(5)) {
        REDERIVE();
        pg8::Gemm g{F.YCAT, F.WOUT, M, D, D}; pg8::StaticOrder S; S.init(M, D, F.G, (int)blockIdx.x);
        pg8::EpiF32 E{F.YF, D};
        pg8::gemm_phase<pg8::EpiF32, pg8::StaticOrder, PG8_ALIGN, PG8_SP2>(F.lds + RING_OFF, g, S, E);
        if (BOTH(5)) GRID_BAR();
    }
    if (IN(6)) { REDERIVE(); p6_rows(F); }
#undef IN
#undef BOTH
}

extern "C" void kernel_launch(void* const* d_in, const int* in_sizes, int n_in, void* d_out, int out_size, void* d_ws, size_t ws_size, hipStream_t stream) {
    static int grid = 0;
    if (grid == 0) {
        if (n_in != 14 || in_sizes[0] != M * D || out_size != M * D || ws_size < WS_END) { fprintf(stderr, "kernel_launch: unexpected shapes (n_in %d, in0 %d, out %d, ws %zu); nothing launched\n", n_in, n_in > 0 ? in_sizes[0] : -1, out_size, ws_size); grid = -1; return; }
        int dev = 0, cus = 0, per_cu = 0;
        if (hipGetDevice(&dev) != hipSuccess || hipDeviceGetAttribute(&cus, hipDeviceAttributeMultiprocessorCount, dev) != hipSuccess) { fprintf(stderr, "kernel_launch: device query failed\n"); grid = -1; return; }
        if (hipFuncSetAttribute((const void*)fwd_kernel, hipFuncAttributeMaxDynamicSharedMemorySize, LDS_BYTES) != hipSuccess) { fprintf(stderr, "kernel_launch: hipFuncSetAttribute failed\n"); grid = -1; return; }
        if (hipOccupancyMaxActiveBlocksPerMultiprocessor(&per_cu, (const void*)fwd_kernel, NWAVES * 64, LDS_BYTES) != hipSuccess || per_cu < 1)
            fprintf(stderr, "kernel_launch: note: occupancy query reports %d workgroups per CU\n", per_cu);
        (void)hipGetLastError();
        grid = cus;
    }
    if (grid < 0) return;
    if (hipMemsetAsync((char*)d_ws + WS_CTL, 0, CTL_ZERO_BYTES, stream) != hipSuccess) { fprintf(stderr, "kernel_launch: memset failed\n"); return; }
    Args a{};
    for (int i = 0; i < 14; ++i) a.in[i] = (const float*)d_in[i];
    a.out = (float*)d_out; a.ws = (unsigned char*)d_ws;
    for (int li = 0; li < N_LAUNCHES; ++li) {
        a.ph_lo = (N_LAUNCHES == 1) ? 0 : li; a.ph_hi = (N_LAUNCHES == 1) ? NPHASE : li + 1; a.li = li;
        hipLaunchKernelGGL(fwd_kernel, dim3(grid), dim3(NWAVES * 64), LDS_BYTES, stream, a);
        const hipError_t le = hipPeekAtLastError();
        if (le != hipSuccess) { fprintf(stderr, "kernel_launch: launch %d failed: %s\n", li, hipGetErrorName(le)); break; }
    }
}
```
